# Optimizing an MI355X kernel written in HIP

```python
import math
import jax, jax.numpy as jnp
from jax import lax
import numpy as np

D_MODEL = 1024
BATCH = 16
SEQ = 2048
DEPTH = 1

DIFF_HEADS = 4
DIFF_HD = 64
DIFF_VD = 2 * DIFF_HD
DIFF_WIDTH = DIFF_HEADS * DIFF_VD
NSA_HEADS = 8
NSA_KV_HEADS = 2
NSA_GROUP = NSA_HEADS // NSA_KV_HEADS
NSA_HD = 64
NSA_WIDTH = NSA_HEADS * NSA_HD
MIX_WIDTH = DIFF_WIDTH + NSA_WIDTH
CMP_LEN = 32
CMP_STRIDE = 16
CMP_HIDDEN = 256
SEL_LEN = 64
SEL_TOPN = 8
WINDOW = 512
Q_BLOCK = 128
FORCE_BONUS = 1000.0
NEG_INF = -1e30
N_BUCKETS = 32
MAX_DISTANCE = 128
N_BIAS_HEADS = DIFF_HEADS + NSA_HEADS
PEER_HEADS = 8
PEER_NKEYS = 128
PEER_EXPERTS = PEER_NKEYS ** 2
PEER_DKEY = 256
PEER_TOPK = 16
PEER_CHUNK = 128
EPS = 1e-6

KV_COLS = NSA_KV_HEADS * NSA_HD
SPLIT_SIZES = (DIFF_HEADS * 2 * DIFF_HD,
               DIFF_HEADS * 2 * DIFF_HD,
               DIFF_WIDTH,
               NSA_WIDTH,
               KV_COLS, KV_COLS,
               KV_COLS, KV_COLS,
               KV_COLS, KV_COLS,
               3 * NSA_HEADS)
IN_COLS = sum(SPLIT_SIZES)
SPLIT_IDX = tuple(int(v) for v in np.cumsum(SPLIT_SIZES)[:-1])

kernel_name = 'hybrid_diffattn_nsa_peer_layer'


def rms_norm(x, g):
    xf = x.astype(jnp.float32)
    y = xf * lax.rsqrt(jnp.mean(xf * xf, axis=-1, keepdims=True) + EPS)
    return (y * g.astype(jnp.float32)).astype(x.dtype)


def t5_bucket(rel):
    n = jnp.maximum(rel, 0)
    max_exact = N_BUCKETS // 2
    nf = jnp.maximum(n, 1).astype(jnp.float32)
    large = max_exact + (jnp.log(nf / max_exact) / math.log(MAX_DISTANCE / max_exact)
                         * (N_BUCKETS - max_exact)).astype(jnp.int32)
    large = jnp.minimum(large, N_BUCKETS - 1)
    return jnp.where(n < max_exact, n, large)


def diff_attention(q, k, v, bias_tab, lq1, lk1, lq2, lk2, subln_g, layer_idx):
    B, S = q.shape[:2]
    nqb = S // Q_BLOCK
    f32 = jnp.float32
    scale = DIFF_HD ** -0.5
    lambda_init = 0.8 - 0.6 * math.exp(-0.3 * layer_idx)
    lam = (jnp.exp(jnp.sum(lq1.astype(f32) * lk1.astype(f32)))
           - jnp.exp(jnp.sum(lq2.astype(f32) * lk2.astype(f32))) + lambda_init)
    qb = q.reshape(B, nqb, Q_BLOCK, DIFF_HEADS, 2, DIFF_HD).swapaxes(0, 1)
    kpos = jnp.arange(S)

    def block(args):
        i, qi = args
        qpos = i * Q_BLOCK + jnp.arange(Q_BLOCK)
        rel = qpos[:, None] - kpos[None, :]
        bias = bias_tab[t5_bucket(rel)].transpose(2, 0, 1)
        s = (jnp.einsum('bqhcd,bkhcd->bhcqk', qi, k).astype(f32) * scale
             + bias[None, :, None].astype(f32))
        s = jnp.where((rel >= 0)[None, None, None], s, NEG_INF)
        p = jax.nn.softmax(s, axis=-1)
        a = p[:, :, 0] - lam * p[:, :, 1]
        return jnp.einsum('bhqk,bkhe->bqhe', a.astype(v.dtype), v)

    o = lax.map(block, (jnp.arange(nqb), qb))
    o = o.swapaxes(0, 1).reshape(B, S, DIFF_HEADS, DIFF_VD)
    o = rms_norm(o, subln_g) * (1.0 - lambda_init)
    return o.reshape(B, S, DIFF_WIDTH)


def compress_blocks(kv, pos_emb, w1, w2):
    B, S, Hkv, d = kv.shape
    n_cmp = (S - CMP_LEN) // CMP_STRIDE + 1
    idx = np.arange(n_cmp)[:, None] * CMP_STRIDE + np.arange(CMP_LEN)[None, :]
    blocks = kv[:, idx] + pos_emb[None, None, :, None, :]
    flat = jnp.moveaxis(blocks, 3, 2).reshape(B, n_cmp, Hkv, CMP_LEN * d)
    return jax.nn.gelu(flat @ w1) @ w2


def cmp_to_sel_matrix(n_cmp, n_sel):
    r = SEL_LEN // CMP_STRIDE
    c = CMP_LEN // CMP_STRIDE
    off = np.arange(n_cmp)[:, None] - r * np.arange(n_sel)[None, :] + (c - 1)
    counts = np.zeros((n_cmp, n_sel), np.float32)
    for n in range(c):
        counts += ((off - n >= 0) & (off - n < r)).astype(np.float32)
    return jnp.asarray(counts)


def nsa_attention(q, kc, vc, ks, vs, kw, vw, gate_logits, bias_tab,
                  pos_k, pos_v, w1_k, w2_k, w1_v, w2_v):
    B, S = q.shape[:2]
    Hkv, G, d = NSA_KV_HEADS, NSA_GROUP, NSA_HD
    f32 = jnp.float32
    scale = d ** -0.5
    qg = q.reshape(B, S, Hkv, G, d)
    pos = jnp.arange(S)

    n_cmp = (S - CMP_LEN) // CMP_STRIDE + 1
    k_cmp = compress_blocks(kc, pos_k, w1_k, w2_k)
    v_cmp = compress_blocks(vc, pos_v, w1_v, w2_v)
    cmp_end = jnp.arange(n_cmp) * CMP_STRIDE + CMP_LEN - 1
    cmp_ok = (cmp_end[None, :] <= pos[:, None])[None, :, None, None]
    s_c = jnp.einsum('bshgd,bchd->bshgc', qg, k_cmp).astype(f32) * scale
    s_c = jnp.where(cmp_ok, s_c, NEG_INF)
    p_c = jnp.where(cmp_ok, jax.nn.softmax(s_c, axis=-1), 0.0)
    o_cmp = jnp.einsum('bshgc,bchd->bshgd', p_c.astype(vc.dtype), v_cmp)

    n_sel = S // SEL_LEN
    top_n = min(SEL_TOPN, n_sel)
    imp = jnp.einsum('bshc,cj->bshj', p_c.sum(axis=3), cmp_to_sel_matrix(n_cmp, n_sel))
    blk = jnp.arange(n_sel)[None, :]
    cur = (pos // SEL_LEN)[:, None]
    sel_ok = (blk <= cur)[None, :, None]
    forced = ((blk == 0) | (blk == cur) | (blk == cur - 1)).astype(f32)[None, :, None]
    score = jnp.where(sel_ok, imp + FORCE_BONUS * forced, NEG_INF)
    top_s, sel_idx = lax.top_k(score, top_n)
    sel_valid = top_s > 0.5 * NEG_INF

    nqb = S // Q_BLOCK
    ks_blk = ks.reshape(B, n_sel, SEL_LEN, Hkv, d)
    vs_blk = vs.reshape(B, n_sel, SEL_LEN, Hkv, d)
    pad = ((0, 0), (WINDOW, 0), (0, 0), (0, 0))
    kw_pad = jnp.pad(kw, pad)
    vw_pad = jnp.pad(vw, pad)
    bias_g = bias_tab.reshape(N_BUCKETS, Hkv, G)
    b_i = jnp.arange(B)[:, None, None, None]
    h_i = jnp.arange(Hkv)[None, None, :, None]
    h_i5 = jnp.arange(Hkv)[None, None, :, None, None]

    def to_blocks(a):
        return a.reshape(B, nqb, Q_BLOCK, *a.shape[2:]).swapaxes(0, 1)

    def block(args):
        i, qb, idx, ok = args
        qpos = i * Q_BLOCK + jnp.arange(Q_BLOCK)
        k_sel = ks_blk[b_i, idx, :, h_i, :]
        v_sel = vs_blk[b_i, idx, :, h_i, :]
        kpos = idx[..., None] * SEL_LEN + jnp.arange(SEL_LEN)
        rel = qpos[None, :, None, None, None] - kpos
        m = (ok[..., None] & (rel >= 0))[:, :, :, None]
        bias = jnp.moveaxis(bias_g[t5_bucket(rel), h_i5], -1, 3)
        s = (jnp.einsum('bqhgd,bqhnld->bqhgnl', qb, k_sel).astype(f32) * scale
             + bias.astype(f32))
        s = jnp.where(m, s, NEG_INF).reshape(B, Q_BLOCK, Hkv, G, top_n * SEL_LEN)
        p = jax.nn.softmax(s, axis=-1)
        o_sel = jnp.einsum('bqhgk,bqhkd->bqhgd', p.astype(vs.dtype),
                           v_sel.reshape(B, Q_BLOCK, Hkv, top_n * SEL_LEN, d))
        k_win = lax.dynamic_slice_in_dim(kw_pad, i * Q_BLOCK, WINDOW + Q_BLOCK, axis=1)
        v_win = lax.dynamic_slice_in_dim(vw_pad, i * Q_BLOCK, WINDOW + Q_BLOCK, axis=1)
        wpos = i * Q_BLOCK - WINDOW + jnp.arange(WINDOW + Q_BLOCK)
        relw = qpos[:, None] - wpos[None, :]
        mw = (relw >= 0) & (relw < WINDOW) & (wpos >= 0)[None, :]
        biasw = bias_g[t5_bucket(relw)].transpose(0, 2, 3, 1)
        sw = (jnp.einsum('bqhgd,bkhd->bqhgk', qb, k_win).astype(f32) * scale
              + biasw[None].astype(f32))
        sw = jnp.where(mw[None, :, None, None, :], sw, NEG_INF)
        pw = jax.nn.softmax(sw, axis=-1)
        o_win = jnp.einsum('bqhgk,bkhd->bqhgd', pw.astype(vw.dtype), v_win)
        return o_sel, o_win

    o_sel, o_win = lax.map(block, (jnp.arange(nqb), to_blocks(qg),
                                   to_blocks(sel_idx), to_blocks(sel_valid)))
    o_sel = o_sel.swapaxes(0, 1).reshape(B, S, Hkv, G, d)
    o_win = o_win.swapaxes(0, 1).reshape(B, S, Hkv, G, d)

    g = jax.nn.sigmoid(gate_logits.astype(f32)).reshape(B, S, Hkv, G, 3)
    o = (g[..., 0:1] * o_cmp.astype(f32) + g[..., 1:2] * o_sel.astype(f32)
         + g[..., 2:3] * o_win.astype(f32))
    return o.astype(q.dtype).reshape(B, S, NSA_WIDTH)


def peer_ffn(x, w_q, sub_keys, u, v):
    B, S, D = x.shape
    xt = x.reshape(B * S // PEER_CHUNK, PEER_CHUNK, D)
    f32 = jnp.float32

    def chunk(xc):
        q = (xc @ w_q).reshape(PEER_CHUNK, PEER_HEADS, 2, PEER_DKEY // 2)
        s = jnp.einsum('chpk,hpnk->chpn', q, sub_keys).astype(f32)
        sv, si = lax.top_k(s, PEER_TOPK)
        cand = sv[:, :, 0, :, None] + sv[:, :, 1, None, :]
        cand_idx = si[:, :, 0, :, None] * PEER_NKEYS + si[:, :, 1, None, :]
        cv, ci = lax.top_k(cand.reshape(PEER_CHUNK, PEER_HEADS, PEER_TOPK * PEER_TOPK), PEER_TOPK)
        e = jnp.take_along_axis(cand_idx.reshape(PEER_CHUNK, PEER_HEADS, -1), ci, axis=-1)
        gate = jax.nn.softmax(cv, axis=-1)
        h = jax.nn.gelu(jnp.einsum('cd,chkd->chk', xc, u[e]).astype(f32))
        return jnp.einsum('chk,chkd->cd', (gate * h).astype(xc.dtype), v[e])

    return lax.map(chunk, xt).reshape(B, S, D)


def setup_inputs(seed: int = 0) -> dict:
    key = jax.random.key(seed)
    ks = jax.random.split(key, 24)
    nrm = lambda k, shape, s: jax.random.normal(k, shape, jnp.float32) * s
    L, D = DEPTH, D_MODEL
    return {
        'x': nrm(ks[0], (BATCH, SEQ, D), 1.0),
        'w_in': nrm(ks[1], (L, D, IN_COLS), D ** -0.5),
        'w_out': nrm(ks[2], (L, MIX_WIDTH, D), MIX_WIDTH ** -0.5),
        'norm_mix_g': 1.0 + nrm(ks[3], (L, D), 0.02),
        'norm_ffn_g': 1.0 + nrm(ks[4], (L, D), 0.02),
        'final_norm_g': 1.0 + nrm(ks[5], (D,), 0.02),
        'rel_bias': nrm(ks[6], (N_BUCKETS, N_BIAS_HEADS), 0.5),
        'diff_lq1': nrm(ks[7], (L, DIFF_HD), 0.1),
        'diff_lk1': nrm(ks[8], (L, DIFF_HD), 0.1),
        'diff_lq2': nrm(ks[9], (L, DIFF_HD), 0.1),
        'diff_lk2': nrm(ks[10], (L, DIFF_HD), 0.1),
        'diff_subln_g': 1.0 + nrm(ks[11], (L, DIFF_VD), 0.02),
        'cmp_pos_k': nrm(ks[12], (L, CMP_LEN, NSA_HD), 0.02),
        'cmp_pos_v': nrm(ks[13], (L, CMP_LEN, NSA_HD), 0.02),
        'cmp_w1_k': nrm(ks[14], (L, CMP_LEN * NSA_HD, CMP_HIDDEN), (CMP_LEN * NSA_HD) ** -0.5),
        'cmp_w2_k': nrm(ks[15], (L, CMP_HIDDEN, NSA_HD), CMP_HIDDEN ** -0.5),
        'cmp_w1_v': nrm(ks[16], (L, CMP_LEN * NSA_HD, CMP_HIDDEN), (CMP_LEN * NSA_HD) ** -0.5),
        'cmp_w2_v': nrm(ks[17], (L, CMP_HIDDEN, NSA_HD), CMP_HIDDEN ** -0.5),
        'peer_w_q': nrm(ks[18], (L, D, PEER_HEADS * PEER_DKEY), D ** -0.5),
        'peer_sub_keys': nrm(ks[19], (L, PEER_HEADS, 2, PEER_NKEYS, PEER_DKEY // 2), (PEER_DKEY // 2) ** -0.5),
        'peer_u': nrm(ks[20], (L, PEER_EXPERTS, D), D ** -0.5),
        'peer_v': nrm(ks[21], (L, PEER_EXPERTS, D), 0.1),
    }


def reference(x, w_in, w_out, norm_mix_g, norm_ffn_g, final_norm_g, rel_bias,
              diff_lq1, diff_lk1, diff_lq2, diff_lk2, diff_subln_g,
              cmp_pos_k, cmp_pos_v, cmp_w1_k, cmp_w2_k, cmp_w1_v, cmp_w2_v,
              peer_w_q, peer_sub_keys, peer_u, peer_v):
    B, S, _ = x.shape
    for l in range(DEPTH):
        h = rms_norm(x, norm_mix_g[l])
        proj = h @ w_in[l]
        dq, dk, dv, nq, kc, vc, ksel, vsel, kwin, vwin, ng = jnp.split(proj, SPLIT_IDX, axis=-1)
        kv_shape = (B, S, NSA_KV_HEADS, NSA_HD)
        o_diff = diff_attention(
            dq.reshape(B, S, DIFF_HEADS, 2, DIFF_HD), dk.reshape(B, S, DIFF_HEADS, 2, DIFF_HD),
            dv.reshape(B, S, DIFF_HEADS, DIFF_VD), rel_bias[:, :DIFF_HEADS],
            diff_lq1[l], diff_lk1[l], diff_lq2[l], diff_lk2[l], diff_subln_g[l], l)
        o_nsa = nsa_attention(
            nq.reshape(B, S, NSA_HEADS, NSA_HD), kc.reshape(kv_shape), vc.reshape(kv_shape),
            ksel.reshape(kv_shape), vsel.reshape(kv_shape), kwin.reshape(kv_shape),
            vwin.reshape(kv_shape), ng, rel_bias[:, DIFF_HEADS:],
            cmp_pos_k[l], cmp_pos_v[l], cmp_w1_k[l], cmp_w2_k[l], cmp_w1_v[l], cmp_w2_v[l])
        x = x + jnp.concatenate([o_diff, o_nsa], axis=-1) @ w_out[l]
        x = x + peer_ffn(rms_norm(x, norm_ffn_g[l]), peer_w_q[l], peer_sub_keys[l],
                         peer_u[l], peer_v[l])
    return rms_norm(x, final_norm_g)
```

```cpp
#include <hip/hip_runtime.h>
#include <hip/hip_cooperative_groups.h>
#include <stdint.h>
#include <stdio.h>
namespace cg = cooperative_groups;

#ifndef MEGA
#define MEGA 1
#endif
#ifndef DBG
#define DBG 0
#endif
#ifndef PEER_AUX
#define PEER_AUX 0
#endif
#ifndef DUP
#define DUP -1
#endif

#define DI __device__ __forceinline__
typedef unsigned short bf16_t;
typedef __attribute__((ext_vector_type(8))) short bf16x8;
typedef __attribute__((ext_vector_type(4))) short s16x4;
typedef __attribute__((ext_vector_type(16))) float f32x16;
typedef __attribute__((ext_vector_type(4))) float f32x4;
typedef __attribute__((ext_vector_type(4))) unsigned u32x4;
typedef __attribute__((ext_vector_type(2))) unsigned u32x2;
typedef __attribute__((address_space(3))) char* lptr;
typedef const __attribute__((address_space(3))) char* lcptr;
typedef short v4i16_t __attribute__((ext_vector_type(4)));

constexpr int NTOK = 32768, DM = 1024, SEQ = 2048, NBATCH = 16;
constexpr size_t SLOT = (size_t)NTOK * 64;
constexpr float LOG2E = 1.4426950408889634f;
constexpr float QSCALE = 0.125f * LOG2E;
constexpr float NEGBIG = -1e30f;
constexpr float RTHR = 8.0f;
constexpr int LDS_BYTES = 73728;

constexpr size_t MiB = (size_t)1 << 20;
constexpr size_t OFF_XN = 0;
constexpr size_t OFF_PROJ = 64 * MiB;
constexpr size_t OFF_GATES = OFF_PROJ + 180 * MiB;
constexpr size_t OFF_ATT = OFF_GATES + 4 * MiB;
constexpr size_t OFF_WINT = OFF_ATT + 64 * MiB;
constexpr size_t OFF_WOUTT = OFF_WINT + 6 * MiB;
constexpr size_t OFF_WQB = OFF_WOUTT + 2 * MiB;
constexpr size_t OFF_SUBK = OFF_WQB + 4 * MiB;
constexpr size_t OFF_WPT = OFF_SUBK + 1 * MiB;
constexpr size_t OFF_U = OFF_WPT + 4 * MiB;
constexpr size_t OFF_V = OFF_U + 32 * MiB;
constexpr size_t OFF_W1KT = OFF_V + 32 * MiB;
constexpr size_t OFF_W1VT = OFF_W1KT + 1 * MiB;
constexpr size_t OFF_W2KT = OFF_W1VT + 1 * MiB;
constexpr size_t OFF_W2VT = OFF_W2KT + 64 * 1024;
constexpr size_t OFF_MISC = OFF_W2VT + 64 * 1024;
constexpr size_t OFF_HID = OFF_MISC + 64 * 1024;
constexpr size_t OFF_KCMP = OFF_HID + 4 * MiB;
constexpr size_t OFF_STASH = OFF_KCMP + 1 * MiB;
constexpr size_t OFF_BAR = OFF_STASH + 64 * MiB;
constexpr size_t OFF_END = OFF_BAR + 64 * 1024;
constexpr size_t OFF_PEER_E = OFF_ATT;
constexpr size_t OFF_PEER_G = OFF_ATT + 16 * MiB;

struct Params {
  const float *x, *w_in, *w_out, *g_mix, *g_ffn, *g_fin, *rel_bias, *lq1, *lk1, *lq2, *lk2, *subln;
  const float *pos_k, *pos_v, *w1k, *w2k, *w1v, *w2v, *wq, *subk, *pu, *pv;
  float* out;
  char* ws;
};

DI int crow(int r, int hi) { return (r & 3) + 8 * (r >> 2) + 4 * hi; }
DI constexpr int crow0(int r) { return (r & 3) + 8 * (r >> 2); }
typedef __bf16 bf16v2_t __attribute__((ext_vector_type(2)));
typedef float f32v2_t __attribute__((ext_vector_type(2)));
DI unsigned cvtpk(float lo, float hi) { return __builtin_bit_cast(unsigned, __builtin_convertvector((f32v2_t){lo, hi}, bf16v2_t)); }
DI bf16_t f2bf(float x) { return (bf16_t)(cvtpk(x, 0.f) & 0xffffu); }
DI float bf2f(bf16_t b) { return __uint_as_float((unsigned)b << 16); }
DI float bflo(unsigned w) { return __uint_as_float(w << 16); }
DI float bfhi(unsigned w) { return __uint_as_float(w & 0xffff0000u); }
#define MFMA32(a, b, c) __builtin_amdgcn_mfma_f32_32x32x16_bf16((a), (b), (c), 0, 0, 0)
DI bf16x8 lds_r128(lcptr p) { return *(const __attribute__((address_space(3))) bf16x8*)p; }
DI void lds_w128(lptr p, u32x4 v) { *(__attribute__((address_space(3))) u32x4*)p = v; }
DI float lds_rf(lcptr p) { return *(const __attribute__((address_space(3))) float*)p; }
DI void lds_wf(lptr p, float v) { *(__attribute__((address_space(3))) float*)p = v; }
DI unsigned lds_ru(lcptr p) { return *(const __attribute__((address_space(3))) unsigned*)p; }
DI void lds_wu(lptr p, unsigned v) { *(__attribute__((address_space(3))) unsigned*)p = v; }
DI s16x4 vtr(lcptr p) { return __builtin_bit_cast(s16x4, __builtin_amdgcn_ds_read_tr16_b64_v4i16((__attribute__((address_space(3))) v4i16_t*)p)); }
DI float wave_sum(float v) {
#pragma unroll
  for (int o = 32; o > 0; o >>= 1) v += __shfl_xor(v, o);
  return v;
}
DI float xor32_max(float m) { auto rr = __builtin_amdgcn_permlane32_swap(__float_as_uint(m), __float_as_uint(m), false, false); return fmaxf(__uint_as_float(rr[0]), __uint_as_float(rr[1])); }
DI float xor32_sum(float m) { auto rr = __builtin_amdgcn_permlane32_swap(__float_as_uint(m), __float_as_uint(m), false, false); return __uint_as_float(rr[0]) + __uint_as_float(rr[1]); }
DI float gelu_tanh(float x) { float y = 1.5957691216057308f * (x + 0.044715f * x * x * x); return x / (1.f + __expf(-y)); }
DI int lane_id() { return __builtin_amdgcn_mbcnt_hi(~0u, __builtin_amdgcn_mbcnt_lo(~0u, 0)); }
DI int task_tid(int wv) { int l; asm volatile("v_mbcnt_lo_u32_b32 %0, -1, 0\n\tv_mbcnt_hi_u32_b32 %0, -1, %0" : "=v"(l)); return wv * 64 + l; }
DI int mbcnt64(unsigned long long m) { return __builtin_amdgcn_mbcnt_hi((unsigned)(m >> 32), __builtin_amdgcn_mbcnt_lo((unsigned)m, 0)); }

DI void transpose_tile(const float* __restrict__ in, int N, bf16_t* __restrict__ out, int K, int tk, int tn, lptr L, int tid) {
#pragma unroll
  for (int i = 0; i < 16; ++i) {
    int e = tid + 256 * i, kk = e >> 6, nn = e & 63, n = tn * 64 + nn;
    float v = (n < N) ? in[(size_t)(tk * 64 + kk) * N + n] : 0.f;
    lds_wf(L + (kk * 65 + nn) * 4, v);
  }
  __syncthreads();
  const int nn = tid >> 2, kc = (tid & 3) * 16;
  unsigned w[8];
#pragma unroll
  for (int i = 0; i < 8; ++i) w[i] = cvtpk(lds_rf(L + ((kc + 2 * i) * 65 + nn) * 4), lds_rf(L + ((kc + 2 * i + 1) * 65 + nn) * 4));
  bf16_t* o = out + (size_t)(tn * 64 + nn) * K + tk * 64 + kc;
  *(u32x4*)o = (u32x4){w[0], w[1], w[2], w[3]};
  *(u32x4*)(o + 8) = (u32x4){w[4], w[5], w[6], w[7]};
  __syncthreads();
}
DI void convert_chunk(const float* __restrict__ in, bf16_t* __restrict__ out, size_t chunk, int tid) {
  size_t i = chunk * 2048 + (size_t)tid * 8;
  f32x4 a = *(const f32x4*)(in + i), b = *(const f32x4*)(in + i + 4);
  *(u32x4*)(out + i) = (u32x4){cvtpk(a[0], a[1]), cvtpk(a[2], a[3]), cvtpk(b[0], b[1]), cvtpk(b[2], b[3])};
}
DI void rmsnorm_rows4_bf16(const float* __restrict__ x0, const float* __restrict__ g, bf16_t* __restrict__ o0, int lane) {
  f32x4 v[4][4];
#pragma unroll
  for (int j = 0; j < 4; ++j)
#pragma unroll
    for (int i = 0; i < 4; ++i) v[j][i] = *(const f32x4*)(x0 + (size_t)j * DM + lane * 4 + 256 * i);
  f32x4 gg[4];
#pragma unroll
  for (int i = 0; i < 4; ++i) gg[i] = *(const f32x4*)(g + lane * 4 + 256 * i);
#pragma unroll
  for (int j = 0; j < 4; ++j) {
    float ss = 0.f;
#pragma unroll
    for (int i = 0; i < 4; ++i) ss += v[j][i][0] * v[j][i][0] + v[j][i][1] * v[j][i][1] + v[j][i][2] * v[j][i][2] + v[j][i][3] * v[j][i][3];
    ss = wave_sum(ss);
    const float rs = rsqrtf(ss * (1.f / 1024.f) + 1e-6f);
#pragma unroll
    for (int i = 0; i < 4; ++i)
      *(u32x2*)(o0 + (size_t)j * DM + lane * 4 + 256 * i) = (u32x2){cvtpk(v[j][i][0] * rs * gg[i][0], v[j][i][1] * rs * gg[i][1]), cvtpk(v[j][i][2] * rs * gg[i][2], v[j][i][3] * rs * gg[i][3])};
  }
}
DI void rmsnorm_row_bf16(const float* __restrict__ xr, const float* __restrict__ g, bf16_t* __restrict__ o, int lane) {
  f32x4 v[4]; float ss = 0.f;
#pragma unroll
  for (int i = 0; i < 4; ++i) { v[i] = *(const f32x4*)(xr + lane * 4 + 256 * i); ss += v[i][0] * v[i][0] + v[i][1] * v[i][1] + v[i][2] * v[i][2] + v[i][3] * v[i][3]; }
  ss = wave_sum(ss);
  const float rs = rsqrtf(ss * (1.f / 1024.f) + 1e-6f);
#pragma unroll
  for (int i = 0; i < 4; ++i) {
    f32x4 gg = *(const f32x4*)(g + lane * 4 + 256 * i);
    *(u32x2*)(o + lane * 4 + 256 * i) = (u32x2){cvtpk(v[i][0] * rs * gg[0], v[i][1] * rs * gg[1]), cvtpk(v[i][2] * rs * gg[2], v[i][3] * rs * gg[3])};
  }
}
DI void quant_row_fp4(const float* __restrict__ in, char* __restrict__ base, int row, int lane) {
  const float* r = in + (size_t)row * DM + lane * 4;
  f32x4 v[4]; float m = 0.f;
#pragma unroll
  for (int i = 0; i < 4; ++i) { v[i] = *(const f32x4*)(r + 256 * i); m = fmaxf(m, fmaxf(fmaxf(fabsf(v[i][0]), fabsf(v[i][1])), fmaxf(fabsf(v[i][2]), fabsf(v[i][3])))); }
#pragma unroll
  for (int o = 32; o > 0; o >>= 1) m = fmaxf(m, __shfl_xor(m, o));
  m = fmaxf(m, 1e-30f);
  const float sc = 6.f / m;
  unsigned w0 = 0u, w1 = 0u;
  w0 = __builtin_amdgcn_cvt_scalef32_pk_fp4_f32(w0, v[0][0] * sc, v[0][1] * sc, 1.0f, 0);
  w0 = __builtin_amdgcn_cvt_scalef32_pk_fp4_f32(w0, v[0][2] * sc, v[0][3] * sc, 1.0f, 1);
  w0 = __builtin_amdgcn_cvt_scalef32_pk_fp4_f32(w0, v[1][0] * sc, v[1][1] * sc, 1.0f, 2);
  w0 = __builtin_amdgcn_cvt_scalef32_pk_fp4_f32(w0, v[1][2] * sc, v[1][3] * sc, 1.0f, 3);
  w1 = __builtin_amdgcn_cvt_scalef32_pk_fp4_f32(w1, v[2][0] * sc, v[2][1] * sc, 1.0f, 0);
  w1 = __builtin_amdgcn_cvt_scalef32_pk_fp4_f32(w1, v[2][2] * sc, v[2][3] * sc, 1.0f, 1);
  w1 = __builtin_amdgcn_cvt_scalef32_pk_fp4_f32(w1, v[3][0] * sc, v[3][1] * sc, 1.0f, 2);
  w1 = __builtin_amdgcn_cvt_scalef32_pk_fp4_f32(w1, v[3][2] * sc, v[3][3] * sc, 1.0f, 3);
  *(u32x2*)(base + (size_t)row * 512 + lane * 8) = (u32x2){w0, w1};
  if (lane == 0) ((float*)(base + 16 * MiB))[row] = m * (1.f / 6.f);
}
DI void quant_rows4_fp4(const float* __restrict__ in, char* __restrict__ base, int row0, int lane) {
  f32x4 v[4][4];
#pragma unroll
  for (int j = 0; j < 4; ++j)
#pragma unroll
    for (int i = 0; i < 4; ++i) v[j][i] = *(const f32x4*)(in + (size_t)(row0 + j) * DM + lane * 4 + 256 * i);
#pragma unroll
  for (int j = 0; j < 4; ++j) {
    float m = 0.f;
#pragma unroll
    for (int i = 0; i < 4; ++i) m = fmaxf(m, fmaxf(fmaxf(fabsf(v[j][i][0]), fabsf(v[j][i][1])), fmaxf(fabsf(v[j][i][2]), fabsf(v[j][i][3]))));
#pragma unroll
    for (int o = 32; o > 0; o >>= 1) m = fmaxf(m, __shfl_xor(m, o));
    m = fmaxf(m, 1e-30f);
    const float sc = 6.f / m;
    unsigned w0 = 0u, w1 = 0u;
    w0 = __builtin_amdgcn_cvt_scalef32_pk_fp4_f32(w0, v[j][0][0] * sc, v[j][0][1] * sc, 1.0f, 0);
    w0 = __builtin_amdgcn_cvt_scalef32_pk_fp4_f32(w0, v[j][0][2] * sc, v[j][0][3] * sc, 1.0f, 1);
    w0 = __builtin_amdgcn_cvt_scalef32_pk_fp4_f32(w0, v[j][1][0] * sc, v[j][1][1] * sc, 1.0f, 2);
    w0 = __builtin_amdgcn_cvt_scalef32_pk_fp4_f32(w0, v[j][1][2] * sc, v[j][1][3] * sc, 1.0f, 3);
    w1 = __builtin_amdgcn_cvt_scalef32_pk_fp4_f32(w1, v[j][2][0] * sc, v[j][2][1] * sc, 1.0f, 0);
    w1 = __builtin_amdgcn_cvt_scalef32_pk_fp4_f32(w1, v[j][2][2] * sc, v[j][2][3] * sc, 1.0f, 1);
    w1 = __builtin_amdgcn_cvt_scalef32_pk_fp4_f32(w1, v[j][3][0] * sc, v[j][3][1] * sc, 1.0f, 2);
    w1 = __builtin_amdgcn_cvt_scalef32_pk_fp4_f32(w1, v[j][3][2] * sc, v[j][3][3] * sc, 1.0f, 3);
    *(u32x2*)(base + (size_t)(row0 + j) * 512 + lane * 8) = (u32x2){w0, w1};
    if (lane == 0) ((float*)(base + 16 * MiB))[row0 + j] = m * (1.f / 6.f);
  }
}
DI int t5_bucket(int n) {
  if (n < 16) return n;
  int b = 16 + (int)(logf((float)n * (1.f / 16.f)) / logf(8.f) * 16.f);
  return b > 31 ? 31 : b;
}
constexpr int T0_WIN = 16 * 46, T0_WOUT = 16 * 16, T0_W1 = 32 * 4, T0_W2 = 4 * 2;
constexpr int T0_A = 0, T0_B = T0_A + T0_WIN, T0_C = T0_B + T0_WOUT, T0_D = T0_C + T0_W1, T0_E = T0_D + T0_W1, T0_F = T0_E + T0_W2, T0_G = T0_F + T0_W2;
constexpr int T0_CVQ = 1024, T0_CVS = 128, T0_CVU = 1024;
constexpr int T0_H = T0_G + T0_CVQ, T0_I = T0_H + T0_CVS, T0_K = T0_I;
constexpr int T0_MISC = 33;
constexpr int T0_L = T0_K + T0_MISC;
constexpr int T0_NORM = NTOK / 16;
constexpr int T0_END = T0_L + T0_NORM;

DI void phase0(const Params& p, lptr L, int wv, int bid, int nb) {
  char* ws = p.ws;
  for (int t0_ = bid; t0_ < T0_END; t0_ += nb) {
    const int t = t0_ < T0_MISC ? T0_K + t0_ : (t0_ < T0_L ? t0_ - T0_MISC : t0_);
    const int tid = task_tid(wv);
    if (t < T0_B) { int q = t - T0_A; transpose_tile(p.w_in, 2840, (bf16_t*)(ws + OFF_WINT), 1024, q / 46, q % 46, L, tid); }
    else if (t < T0_C) { int q = t - T0_B; transpose_tile(p.w_out, 1024, (bf16_t*)(ws + OFF_WOUTT), 1024, q / 16, q % 16, L, tid); }
    else if (t < T0_D) { int q = t - T0_C; transpose_tile(p.w1k, 256, (bf16_t*)(ws + OFF_W1KT), 2048, q / 4, q % 4, L, tid); }
    else if (t < T0_E) { int q = t - T0_D; transpose_tile(p.w1v, 256, (bf16_t*)(ws + OFF_W1VT), 2048, q / 4, q % 4, L, tid); }
    else if (t < T0_F) { int q = t - T0_E; transpose_tile(p.w2k, 64, (bf16_t*)(ws + OFF_W2KT), 256, q / 2, q % 2, L, tid); }
    else if (t < T0_G) { int q = t - T0_F; transpose_tile(p.w2v, 64, (bf16_t*)(ws + OFF_W2VT), 256, q / 2, q % 2, L, tid); }
    else if (t < T0_H) convert_chunk(p.wq, (bf16_t*)(ws + OFF_WQB), t - T0_G, tid);
    else if (t < T0_I) convert_chunk(p.subk, (bf16_t*)(ws + OFF_SUBK), t - T0_H, tid);
    else if (t < T0_L) {
      int q = t - T0_K;
      float* misc = (float*)(ws + OFF_MISC);
      if (q < 32) {
        const int which = q >> 4, ch = q & 15;
        const float* pos = (which ? p.pos_v : p.pos_k) + ch * 128; const float* w1 = (which ? p.w1v : p.w1k) + (size_t)ch * 128 * 256;
        float a0 = 0.f, a1 = 0.f, a2 = 0.f, a3 = 0.f;
#pragma unroll 8
        for (int i = 0; i < 128; i += 4) {
          a0 += pos[i] * w1[(size_t)i * 256 + tid]; a1 += pos[i + 1] * w1[(size_t)(i + 1) * 256 + tid];
          a2 += pos[i + 2] * w1[(size_t)(i + 2) * 256 + tid]; a3 += pos[i + 3] * w1[(size_t)(i + 3) * 256 + tid];
        }
        misc[8192 + (which * 16 + ch) * 256 + tid] = (a0 + a1) + (a2 + a3);
      } else {
        float* btab = misc + 1024;
        for (int e = tid; e < 12 * 256; e += 256) { int h = e >> 8, rel = e & 255; btab[e] = p.rel_bias[t5_bucket(rel) * 12 + h] * LOG2E; }
        if (tid < 64) {
          float a = wave_sum(p.lq1[tid] * p.lk1[tid]), b = wave_sum(p.lq2[tid] * p.lk2[tid]);
          if (tid == 0) misc[512] = __expf(a) - __expf(b) + 0.2f;
        }
      }
    } else {
      const int row = (t - T0_L) * 16 + wv * 4;
      rmsnorm_rows4_bf16(p.x + (size_t)row * DM, p.g_mix, (bf16_t*)(ws + OFF_XN) + (size_t)row * DM, tid & 63);
    }
  }
}

DI void glds16(const bf16_t* g, lptr l) {
  __builtin_amdgcn_global_load_lds((const unsigned*)g, (__attribute__((address_space(3))) unsigned*)l, 16, 0, 0);
}
template <class Epi>
DI void gemm_tile(const bf16_t* __restrict__ A, int lda, const bf16_t* __restrict__ Bt, int ldb, int K, int m0, int n0, lptr L, int wv, const Epi& epi) {
  const int tid = task_tid(wv);
  const int lane = tid & 63, w = tid >> 6, r32 = lane & 31, hi = lane >> 5;
  const int wm = w >> 1, wn = w & 1;
  const int srow = tid >> 3, sch = (tid & 7) ^ ((tid >> 4) & 7);
  const bf16_t* ag = A + (size_t)(m0 + srow) * lda + sch * 8;
  const bf16_t* bg = Bt + (size_t)(n0 + srow) * ldb + sch * 8;
  f32x16 acc[2][2];
#pragma unroll
  for (int i = 0; i < 2; ++i)
#pragma unroll
    for (int j = 0; j < 2; ++j)
#pragma unroll
      for (int r = 0; r < 16; ++r) acc[i][j][r] = 0.f;
#define G_STAGE(buf, k0) do { lptr d_ = L + (buf) * 32768 + tid * 16; _Pragma("unroll") for (int i_ = 0; i_ < 4; ++i_) { \
      glds16(ag + (size_t)(32 * i_) * lda + (k0), d_ + i_ * 4096); glds16(bg + (size_t)(32 * i_) * ldb + (k0), d_ + 16384 + i_ * 4096); } } while (0)
  const int sw = (r32 >> 1) & 7;
  int co[4];
#pragma unroll
  for (int ks = 0; ks < 4; ++ks) co[ks] = (((2 * ks + hi) ^ sw) * 16);
  lcptr abase = L + (wm * 64 + r32) * 128, bbase = L + 16384 + (wn * 64 + r32) * 128;
  const int nk = K >> 6;
  G_STAGE(0, 0);
  asm volatile("s_waitcnt vmcnt(0)" ::: "memory");
  __syncthreads();
#define G_BODY(DMA) do { \
    lcptr a = abase + (kt & 1) * 32768, b = bbase + (kt & 1) * 32768; \
    lptr dn = L + ((kt + 1) & 1) * 32768 + tid * 16; const int k1 = (kt + 1) * 64; \
    _Pragma("unroll") for (int ks = 0; ks < 4; ++ks) { \
      bf16x8 a0 = lds_r128(a + co[ks]), a1 = lds_r128(a + 32 * 128 + co[ks]); \
      bf16x8 b0 = lds_r128(b + co[ks]), b1 = lds_r128(b + 32 * 128 + co[ks]); \
      acc[0][0] = MFMA32(a0, b0, acc[0][0]); \
      if (DMA && ks < 2) glds16(ag + (size_t)(64 * ks) * lda + k1, dn + ks * 8192); \
      acc[0][1] = MFMA32(a0, b1, acc[0][1]); \
      if (DMA && ks < 2) glds16(bg + (size_t)(64 * ks) * ldb + k1, dn + 16384 + ks * 8192); \
      acc[1][0] = MFMA32(a1, b0, acc[1][0]); \
      if (DMA && ks < 2) glds16(ag + (size_t)(64 * ks + 32) * lda + k1, dn + ks * 8192 + 4096); \
      acc[1][1] = MFMA32(a1, b1, acc[1][1]); \
      if (DMA && ks < 2) glds16(bg + (size_t)(64 * ks + 32) * ldb + k1, dn + 16384 + ks * 8192 + 4096); \
    } \
    asm volatile("s_waitcnt vmcnt(0)" ::: "memory"); \
    __syncthreads(); } while (0)
  int kt = 0;
  for (; kt + 1 < nk; ++kt) G_BODY(1);
  G_BODY(0);
#undef G_BODY
#undef G_STAGE
  {
    lptr st = L + ((wm * 64 + 4 * hi) * 132 + wn * 64 + r32) * 4;
#pragma unroll
    for (int i = 0; i < 2; ++i)
#pragma unroll
      for (int j = 0; j < 2; ++j)
#pragma unroll
        for (int r = 0; r < 16; ++r) lds_wf(st + ((i * 32 + crow0(r)) * 132 + j * 32) * 4, acc[i][j][r]);
  }
  __syncthreads();
  {
    const int c4 = tid & 31, rr = tid >> 5;
#pragma unroll 4
    for (int it = 0; it < 16; ++it) {
      const int row = it * 8 + rr;
      const f32x4 v = *(const __attribute__((address_space(3))) f32x4*)(L + (row * 132 + c4 * 4) * 4);
      epi(m0 + row, n0 + c4 * 4, v);
    }
  }
  __syncthreads();
}

template <class F>
DI void for_each_tile_patched(int bid, int nb, int MT, int NT, const F& f) {
  if (nb == 512) {
    const int x = bid & 7, i = bid >> 3, pcols = (NT + 7) >> 3, npatch = (MT >> 3) * pcols;
    for (int pidx = x; pidx < npatch; pidx += 8) {
      const int mt = (pidx / pcols) * 8 + (i >> 3), nt = (pidx % pcols) * 8 + (i & 7);
      if (nt < NT) f(mt, nt);
    }
  } else {
    for (int t = bid; t < MT * NT; t += nb) f(t / NT, t % NT);
  }
}
struct EpiInProj {
  bf16_t* proj; float* gates;
  DI void operator()(int row, int col, const f32x4& v) const {
    if (col < 2816) {
      const int slot = col >> 6, d = col & 63;
      const float sc = (slot < 8 || (slot >= 24 && slot < 32)) ? QSCALE : 1.f;
      *(u32x2*)(proj + (size_t)slot * SLOT + (size_t)row * 64 + d) = (u32x2){cvtpk(v[0] * sc, v[1] * sc), cvtpk(v[2] * sc, v[3] * sc)};
    } else if (col < 2840) {
      *(f32x4*)(gates + (size_t)row * 24 + (col - 2816)) = v;
    }
  }
};
struct EpiBf16 {
  bf16_t* c; int ldc; int ncols;
  DI void operator()(int row, int col, const f32x4& v) const {
    if (col < ncols) *(u32x2*)(c + (size_t)row * ldc + col) = (u32x2){cvtpk(v[0], v[1]), cvtpk(v[2], v[3])};
  }
};
struct EpiGeluBias {
  bf16_t* c; int ldc; const float* cb;
  DI void operator()(int row, int col, const f32x4& v) const {
    f32x4 b = {0.f, 0.f, 0.f, 0.f};
#pragma unroll
    for (int i = 0; i < 16; ++i) { const f32x4 t = *(const f32x4*)(cb + i * 256 + col); b += t; }
    *(u32x2*)(c + (size_t)row * ldc + col) = (u32x2){cvtpk(gelu_tanh(v[0] + b[0]), gelu_tanh(v[1] + b[1])), cvtpk(gelu_tanh(v[2] + b[2]), gelu_tanh(v[3] + b[3]))};
  }
};
struct EpiResid {
  const float* x; bf16_t* o;
  DI void operator()(int row, int col, const f32x4& v) const {
    const size_t i = (size_t)row * DM + col;
    const f32x4 xv = *(const f32x4*)(x + i);
    *(u32x2*)(o + i) = (u32x2){cvtpk(xv[0] + v[0], xv[1] + v[1]), cvtpk(xv[2] + v[2], xv[3] + v[3])};
  }
};

constexpr int T1_IN = 256 * 23, T1_END = T1_IN + 128;
DI void phase1(const Params& p, lptr L, int wv, int bid, int nb) {
  char* ws = p.ws;
  for (int q = bid; q < 128; q += nb) {
    const int hp = q >> 3, dt = q & 7;
    EpiBf16 e{(bf16_t*)(ws + OFF_WPT) + (size_t)hp * 128 * DM, DM, DM};
    gemm_tile((const bf16_t*)(ws + OFF_SUBK) + (size_t)hp * 128 * 128, 128, (const bf16_t*)(ws + OFF_WQB) + hp * 128, 2048, 128, 0, dt * 128, L, wv, e);
  }
  for_each_tile_patched(bid, nb, 256, 23, [&](int mt, int nt) {
    EpiInProj e{(bf16_t*)(ws + OFF_PROJ), (float*)(ws + OFF_GATES)};
    gemm_tile((const bf16_t*)(ws + OFF_XN), DM, (const bf16_t*)(ws + OFF_WINT), DM, DM, mt * 128, nt * 128, L, wv, e);
  });
  for (int q = bid; q < 2 * T0_CVU; q += nb) {
    const int lane = task_tid(wv) & 63;
    if (q < T0_CVU) quant_rows4_fp4(p.pu, ws + OFF_U, q * 16 + wv * 4, lane);
    else quant_rows4_fp4(p.pv, ws + OFF_V, (q - T0_CVU) * 16 + wv * 4, lane);
  }
}

template <int NDB, class Adj>
DI void flash_tile(lcptr Kt, lcptr Vt, const bf16x8 (&q)[4], f32x16 (&o)[NDB], float& mref, float& lsum, lptr wsf, int lane, const Adj& adj, bool first) {
  const int r32 = lane & 31, hi = lane >> 5;
  const float c = adj.base() - mref;
  f32x16 p0, p1;
#pragma unroll
  for (int r = 0; r < 16; ++r) { p0[r] = c; p1[r] = c; }
  lcptr kp = Kt + r32 * 128;
  const int ksw = (r32 >> 1) & 7;
#pragma unroll
  for (int s = 0; s < 4; ++s) {
    const int kc = ((2 * s + hi) ^ ksw) * 16;
    bf16x8 k0 = lds_r128(kp + kc), k1 = lds_r128(kp + 32 * 128 + kc);
    p0 = MFMA32(k0, q[s], p0); p1 = MFMA32(k1, q[s], p1);
  }
  adj(p0, 0); adj(p1, 32);
  float rm = p0[0];
#pragma unroll
  for (int r = 1; r < 16; ++r) rm = fmaxf(rm, p0[r]);
#pragma unroll
  for (int r = 0; r < 16; ++r) rm = fmaxf(rm, p1[r]);
  rm = xor32_max(rm);
  if (__any(first || rm > RTHR)) {
    const float d = first ? fmaxf(rm, -1000.f) : fmaxf(rm, 0.f);
    const float f = first ? 1.f : __builtin_amdgcn_exp2f(-d);
    mref += d; lsum *= f;
    if (hi == 0) lds_wf(wsf + r32 * 4, f);
#pragma unroll
    for (int r = 0; r < 16; ++r) {
      const float fr = lds_rf(wsf + hi * 16 + crow0(r) * 4);
#pragma unroll
      for (int db = 0; db < NDB; ++db) o[db][r] *= fr;
    }
#pragma unroll
    for (int r = 0; r < 16; ++r) { p0[r] -= d; p1[r] -= d; }
  }
  float s = 0.f;
#pragma unroll
  for (int r = 0; r < 16; ++r) { p0[r] = __builtin_amdgcn_exp2f(p0[r]); p1[r] = __builtin_amdgcn_exp2f(p1[r]); s += p0[r] + p1[r]; }
  lsum += s;
  bf16x8 pw[4];
  pw[0] = __builtin_bit_cast(bf16x8, (u32x4){cvtpk(p0[0], p0[1]), cvtpk(p0[2], p0[3]), cvtpk(p0[4], p0[5]), cvtpk(p0[6], p0[7])});
  pw[1] = __builtin_bit_cast(bf16x8, (u32x4){cvtpk(p0[8], p0[9]), cvtpk(p0[10], p0[11]), cvtpk(p0[12], p0[13]), cvtpk(p0[14], p0[15])});
  pw[2] = __builtin_bit_cast(bf16x8, (u32x4){cvtpk(p1[0], p1[1]), cvtpk(p1[2], p1[3]), cvtpk(p1[4], p1[5]), cvtpk(p1[6], p1[7])});
  pw[3] = __builtin_bit_cast(bf16x8, (u32x4){cvtpk(p1[8], p1[9]), cvtpk(p1[10], p1[11]), cvtpk(p1[12], p1[13]), cvtpk(p1[14], p1[15])});
  lcptr vp = Vt + (4 * hi + ((lane & 15) >> 2)) * 64 + ((lane >> 4) & 1) * 32 + (lane & 3) * 8;
#pragma unroll
  for (int db = 0; db < NDB; ++db)
#pragma unroll
    for (int s4 = 0; s4 < 4; ++s4) {
      s16x4 lo = vtr(vp + db * 4096 + s4 * 1024), hh = vtr(vp + db * 4096 + s4 * 1024 + 512);
      bf16x8 vf = (bf16x8){lo[0], lo[1], lo[2], lo[3], hh[0], hh[1], hh[2], hh[3]};
      o[db] = MFMA32(pw[s4], vf, o[db]);
    }
}
DI void load_q(bf16x8 (&q)[4], const bf16_t* qrow, int hi) {
#pragma unroll
  for (int s = 0; s < 4; ++s) q[s] = *(const bf16x8*)(qrow + s * 16 + hi * 8);
}

struct AdjDiff {
  lcptr ab; bool far; float bfar;
  DI float base() const { return far ? bfar : 0.f; }
  DI void operator()(f32x16& p, int koff) const {
    if (!far) {
#pragma unroll
      for (int r = 0; r < 16; ++r) p[r] += lds_rf(ab + (koff + crow0(r)) * 4);
    }
  }
};
constexpr int DIFF_M0 = 224, DIFF_TM = 288;
constexpr int DIFF_BUF = 32768;
constexpr int DIFF_WSF = 2 * DIFF_BUF;
constexpr int DIFF_BTAB = DIFF_WSF + 1024;
DI void diff_task(const Params& p, lptr L, int wv, int b, int h, int qt) {
  char* ws = p.ws; asm volatile("" : "+s"(ws));
  const int tid = task_tid(wv);
  const int lane = tid & 63, w = tid >> 6, r32 = lane & 31, hi = lane >> 5;
  const int comp = w & 1, half = w >> 1;
  const bf16_t* proj = (const bf16_t*)(ws + OFF_PROJ);
  const float* misc = (const float*)(ws + OFF_MISC);
  const int t0 = qt * 64;
  const size_t tokbase = (size_t)b * SEQ;
  for (int m = tid; m < DIFF_TM; m += 256) { const int rel = DIFF_M0 - m; lds_wf(L + DIFF_BTAB + m * 4, rel < 0 ? NEGBIG : misc[1024 + h * 256 + (rel > 255 ? 255 : rel)]); }
  const float bfar = misc[1024 + h * 256 + 255];
  const int qpos = t0 + half * 32 + r32;
  bf16x8 q[4];
  load_q(q, proj + (size_t)(2 * h + comp) * SLOT + (tokbase + qpos) * 64, hi);
  f32x16 o[4];
#pragma unroll
  for (int db = 0; db < 4; ++db)
#pragma unroll
    for (int r = 0; r < 16; ++r) o[db][r] = 0.f;
  float mref = 0.f, lsum = 0.f;
  lptr wsf = L + DIFF_WSF + w * 256;
  const int NT = qt + 1;
  const bf16_t* k0g = proj + (size_t)(8 + 2 * h) * SLOT + tokbase * 64;
  const bf16_t* k1g = proj + (size_t)(9 + 2 * h) * SLOT + tokbase * 64;
  const bf16_t* v0g = proj + (size_t)(16 + 2 * h) * SLOT + tokbase * 64;
  const bf16_t* v1g = proj + (size_t)(17 + 2 * h) * SLOT + tokbase * 64;
  const int krow = tid >> 3, kch = (tid & 7) ^ ((tid >> 4) & 7);
  const int vkey = tid >> 2, vc = tid & 3;
#define D_STAGE(buf, j) do { const size_t kb_ = (size_t)(j) * 64; lptr b_ = L + (buf) * DIFF_BUF + tid * 16; \
      glds16(k0g + (kb_ + krow) * 64 + kch * 8, b_); glds16(k0g + (kb_ + krow + 32) * 64 + kch * 8, b_ + 4096); \
      glds16(k1g + (kb_ + krow) * 64 + kch * 8, b_ + 8192); glds16(k1g + (kb_ + krow + 32) * 64 + kch * 8, b_ + 12288); \
      glds16(v0g + (kb_ + vkey) * 64 + vc * 8, b_ + 16384); glds16(v0g + (kb_ + vkey) * 64 + 32 + vc * 8, b_ + 20480); \
      glds16(v1g + (kb_ + vkey) * 64 + vc * 8, b_ + 24576); glds16(v1g + (kb_ + vkey) * 64 + 32 + vc * 8, b_ + 28672); } while (0)
  D_STAGE(0, 0);
  asm volatile("s_waitcnt vmcnt(0)" ::: "memory");
  __syncthreads();
  for (int j = 0; j < NT; ++j) {
    if (j + 1 < NT) D_STAGE((j + 1) & 1, j + 1);
    lcptr bufp = L + (j & 1) * DIFF_BUF;
    AdjDiff adj{L + DIFF_BTAB + (DIFF_M0 - (qpos - j * 64 - 4 * hi)) * 4, (t0 + half * 32) - (j * 64 + 63) >= 128, bfar};
    flash_tile<4>(bufp + comp * 8192, bufp + 16384, q, o, mref, lsum, wsf, lane, adj, j == 0);
    asm volatile("s_waitcnt vmcnt(0)" ::: "memory");
    __syncthreads();
  }
#undef D_STAGE
  lsum = xor32_sum(lsum);
  if (hi == 0) lds_wf(wsf + r32 * 4, 1.f / lsum);
  float il[16];
#pragma unroll
  for (int r = 0; r < 16; ++r) il[r] = lds_rf(wsf + hi * 16 + crow0(r) * 4);
  const float lam = misc[512];
  lptr X = L;
  lptr Xb = X + ((half * 32 + 4 * hi) * 132 + r32) * 4;
  if (comp == 1) {
#pragma unroll
    for (int db = 0; db < 4; ++db)
#pragma unroll
      for (int r = 0; r < 16; ++r) lds_wf(Xb + (crow0(r) * 132 + db * 32) * 4, o[db][r] * il[r] * lam);
  }
  __syncthreads();
  if (comp == 0) {
#pragma unroll
    for (int db = 0; db < 4; ++db)
#pragma unroll
      for (int r = 0; r < 16; ++r) {
        lptr a = Xb + (crow0(r) * 132 + db * 32) * 4;
        lds_wf(a, o[db][r] * il[r] - lds_rf(a));
      }
  }
  __syncthreads();
  {
    const int tok = tid >> 2, part = tid & 3;
    float v[32]; float ss = 0.f;
#pragma unroll
    for (int i = 0; i < 32; ++i) { v[i] = lds_rf(X + (tok * 132 + part * 32 + i) * 4); ss += v[i] * v[i]; }
    ss += __shfl_xor(ss, 1); ss += __shfl_xor(ss, 2);
    const float rs = rsqrtf(ss * (1.f / 128.f) + 1e-6f) * 0.8f;
    const float* g = p.subln + part * 32;
    bf16_t* op = (bf16_t*)(ws + OFF_ATT) + (tokbase + t0 + tok) * DM + h * 128 + part * 32;
#pragma unroll
    for (int i = 0; i < 4; ++i) {
      u32x4 wv;
#pragma unroll
      for (int k = 0; k < 4; ++k) wv[k] = cvtpk(v[i * 8 + 2 * k] * rs * g[i * 8 + 2 * k], v[i * 8 + 2 * k + 1] * rs * g[i * 8 + 2 * k + 1]);
      *(u32x4*)(op + i * 8) = wv;
    }
  }
  __syncthreads();
}
constexpr int T2_CMP = 2 * 32 * 2, T2_DIFF = 2048, T2_END = T2_CMP + T2_DIFF;
DI void phase2(const Params& p, lptr L, int wv, int bid, int nb) {
  char* ws = p.ws;
  for (int t = bid; t < T2_END; t += nb) {
    if (t < T2_CMP) {
      const int which = t >> 6, mt = (t >> 1) & 31, nt = t & 1;
      EpiGeluBias e{(bf16_t*)(ws + OFF_HID) + (size_t)which * 4096 * 256, 256, (const float*)(ws + OFF_MISC) + 8192 + which * 16 * 256};
      gemm_tile((const bf16_t*)(ws + OFF_PROJ) + (size_t)(32 + 2 * which) * SLOT, 1024, (const bf16_t*)(ws + (which ? OFF_W1VT : OFF_W1KT)), 2048, 2048, mt * 128, nt * 128, L, wv, e);
    } else {
      const int q = t - T2_CMP, qt = 31 - (q >> 6), bh = q & 63;
      diff_task(p, L, wv, bh >> 2, bh & 3, qt);
    }
  }
}
constexpr int T2B_END = 2 * 32;
DI void phase2b(const Params& p, lptr L, int wv, int bid, int nb) {
  char* ws = p.ws;
  for (int t = bid; t < T2B_END; t += nb) {
    const int which = t >> 5, mt = t & 31;
    EpiBf16 e{(bf16_t*)(ws + OFF_KCMP) + (size_t)which * 4096 * 64, 64, 64};
    gemm_tile((const bf16_t*)(ws + OFF_HID) + (size_t)which * 4096 * 256, 256, (const bf16_t*)(ws + (which ? OFF_W2VT : OFF_W2KT)), 256, 256, mt * 128, 0, L, wv, e);
  }
}

constexpr int NSA_TILE = 16384;
constexpr int NSA_PSUM = 34816;
constexpr int NSA_SC = NSA_PSUM + 16512;
constexpr int NSA_SELM = NSA_SC + 4608;
constexpr int NSA_WSF = NSA_SELM + 128;
constexpr int NSA_BTAB = NSA_WSF + 4096;
struct AdjSel {
  lcptr ab; bool far; bool on; float bfar;
  DI float base() const { return on ? (far ? bfar : 0.f) : NEGBIG; }
  DI void operator()(f32x16& p, int koff) const {
    if (!far) {
#pragma unroll
      for (int r = 0; r < 16; ++r) p[r] += lds_rf(ab + (koff + crow0(r)) * 4);
    }
  }
};
struct AdjWin {
  lcptr ab; bool mid; float bfar;
  DI float base() const { return mid ? bfar : 0.f; }
  DI void operator()(f32x16& p, int koff) const {
    if (!mid) {
#pragma unroll
      for (int r = 0; r < 16; ++r) p[r] += lds_rf(ab + (koff + crow0(r)) * 4);
    }
  }
};
constexpr int NSA_M0 = 608, NSA_TM = 672;
static_assert(NSA_BTAB + 4 * NSA_TM * 4 <= LDS_BYTES - 16, "nsa lds");
DI void nsa_task(const Params& p, lptr L, int wv, int b, int hkv, int qt, int task) {
  char* ws = p.ws; asm volatile("" : "+s"(ws));
  const int tid = task_tid(wv);
  const int lane = tid & 63, w = tid >> 6, r32 = lane & 31, hi = lane >> 5;
  const bf16_t* proj = (const bf16_t*)(ws + OFF_PROJ);
  const float* misc = (const float*)(ws + OFF_MISC);
  const int t0 = qt * 32, hq = hkv * 4 + w;
  const size_t tokbase = (size_t)b * SEQ;
  const int qpos = t0 + r32;
  const int cur = t0 >> 6;
  lptr wsf = L + NSA_WSF + w * 1024;
#pragma unroll
  for (int e = tid; e < 4 * NSA_TM; e += 256) {
    const int i = e / NSA_TM, rel = NSA_M0 - (e - i * NSA_TM);
    lds_wf(L + NSA_BTAB + e * 4, (rel < 0 || rel > 511) ? NEGBIG : misc[1024 + (4 + hkv * 4 + i) * 256 + (rel > 255 ? 255 : rel)]);
  }
  lcptr btab = L + NSA_BTAB + w * (NSA_TM * 4);
  const float bfar = misc[1024 + (4 + hq) * 256 + 255];
  bf16x8 q[4];
  load_q(q, proj + (size_t)(24 + hq) * SLOT + (tokbase + qpos) * 64, hi);
  const float* gl = (const float*)(ws + OFF_GATES) + (tokbase + qpos) * 24 + hq * 3;
  lptr wscr = wsf + 384;
  f32x16 res[2];

  {
    const bf16_t* kc = (const bf16_t*)(ws + OFF_KCMP) + (size_t)((hkv * 16 + b) * 128) * 64;
    const bf16_t* vc = kc + (size_t)4096 * 64;
    const int key0 = tid >> 3, ch = tid & 7;
    const bf16_t* kcp = kc + key0 * 64 + ch * 8; const bf16_t* vcp = vc + key0 * 64 + ch * 8;
    lptr kd = L + key0 * 128 + ((ch ^ ((key0 >> 1) & 7)) * 16), vd = L + 18432 + (ch >> 2) * 8192 + key0 * 64 + (ch & 3) * 16;
#pragma unroll
    for (int i = 0; i < 4; ++i) {
      u32x4 kk = *(const u32x4*)(kcp + i * 32 * 64), vv = *(const u32x4*)(vcp + i * 32 * 64);
      lds_w128(kd + i * 32 * 128, kk);
      lds_w128(vd + i * 32 * 64, vv);
    }
  }
  __syncthreads();
  {
    f32x16 ocmp[2];
    f32x16 pc[4];
#pragma unroll
    for (int kb = 0; kb < 4; ++kb) {
#pragma unroll
      for (int r = 0; r < 16; ++r) pc[kb][r] = 0.f;
      lcptr kp = L + (kb * 32 + r32) * 128;
#pragma unroll
      for (int s = 0; s < 4; ++s) pc[kb] = MFMA32(lds_r128(kp + (((2 * s + hi) ^ ((r32 >> 1) & 7)) * 16)), q[s], pc[kb]);
    }
    const int nvalid = qpos >= 31 ? ((qpos - 31) >> 4) + 1 : 0;
    const int nvh = nvalid - 4 * hi;
    float rm = NEGBIG;
#pragma unroll
    for (int kb = 0; kb < 4; ++kb)
#pragma unroll
      for (int r = 0; r < 16; ++r) { const bool ok = (kb * 32 + crow0(r)) < nvh; pc[kb][r] = ok ? pc[kb][r] : NEGBIG; rm = fmaxf(rm, pc[kb][r]); }
    rm = xor32_max(rm);
    float s = 0.f;
#pragma unroll
    for (int kb = 0; kb < 4; ++kb)
#pragma unroll
      for (int r = 0; r < 16; ++r) { pc[kb][r] = __builtin_amdgcn_exp2f(pc[kb][r] - rm); s += pc[kb][r]; }
    s = xor32_sum(s);
    const float inv = nvalid > 0 ? 1.f / s : 0.f;
#pragma unroll
    for (int kb = 0; kb < 4; ++kb)
#pragma unroll
      for (int r = 0; r < 16; ++r) pc[kb][r] *= inv;
#pragma unroll
    for (int db = 0; db < 2; ++db)
#pragma unroll
      for (int r = 0; r < 16; ++r) ocmp[db][r] = 0.f;
    lcptr vp = L + 18432 + (4 * hi + ((lane & 15) >> 2)) * 64 + ((lane >> 4) & 1) * 32 + (lane & 3) * 8;
#pragma unroll
    for (int s8 = 0; s8 < 8; ++s8) {
      const int kb = s8 >> 1, r0 = (s8 & 1) * 8;
      bf16x8 pw = __builtin_bit_cast(bf16x8, (u32x4){cvtpk(pc[kb][r0], pc[kb][r0 + 1]), cvtpk(pc[kb][r0 + 2], pc[kb][r0 + 3]), cvtpk(pc[kb][r0 + 4], pc[kb][r0 + 5]), cvtpk(pc[kb][r0 + 6], pc[kb][r0 + 7])});
#pragma unroll
      for (int db = 0; db < 2; ++db) {
        s16x4 lo = vtr(vp + db * 8192 + s8 * 1024), hh = vtr(vp + db * 8192 + s8 * 1024 + 512);
        bf16x8 vf = (bf16x8){lo[0], lo[1], lo[2], lo[3], hh[0], hh[1], hh[2], hh[3]};
        ocmp[db] = MFMA32(pw, vf, ocmp[db]);
      }
    }
    if (hi == 0) lds_wf(wscr + 128 + r32 * 4, 1.f / (1.f + __expf(-gl[0])));
#pragma unroll
    for (int r = 0; r < 16; ++r) {
      const float g0 = lds_rf(wscr + hi * 16 + 128 + crow0(r) * 4);
#pragma unroll
      for (int db = 0; db < 2; ++db) { res[db][r] = g0 * ocmp[db][r]; asm volatile("" : "+v"(res[db][r])); }
    }
#pragma nounroll
    for (int g = 0; g < 4; ++g) {
      if (w == g) {
#pragma unroll
        for (int kb = 0; kb < 4; ++kb)
#pragma unroll
          for (int r = 0; r < 16; ++r) {
            lptr a = L + NSA_PSUM + (r32 * 129 + 4 * hi) * 4 + (kb * 32 + crow0(r)) * 4;
            lds_wf(a, g == 0 ? pc[kb][r] : lds_rf(a) + pc[kb][r]);
          }
      }
      __syncthreads();
    }
  }
  {
    const int tok = tid >> 3, sub = tid & 7;
    lcptr ps = L + NSA_PSUM + tok * 129 * 4;
#pragma unroll
    for (int jj = 0; jj < 4; ++jj) {
      const int j = sub * 4 + jj;
      float imp = 2.f * (lds_rf(ps + (4 * j) * 4) + lds_rf(ps + (4 * j + 1) * 4) + lds_rf(ps + (4 * j + 2) * 4)) + lds_rf(ps + (4 * j + 3) * 4);
      if (j > 0) imp += lds_rf(ps + (4 * j - 1) * 4);
      const bool forced = (j == 0) || (j == cur) || (j == cur - 1);
      const float sc = (j <= cur) ? imp + (forced ? 1000.f : 0.f) : NEGBIG;
      lds_wf(L + NSA_SC + (tok * 36 + j) * 4, sc);
    }
  }
  __syncthreads();
  {
    const int tok = tid >> 3, sub = tid & 7;
    float sv[32];
#pragma unroll
    for (int c = 0; c < 8; ++c) {
      const f32x4 t4 = *(const __attribute__((address_space(3))) f32x4*)(L + NSA_SC + (tok * 36 + c * 4) * 4);
      sv[4 * c] = t4[0]; sv[4 * c + 1] = t4[1]; sv[4 * c + 2] = t4[2]; sv[4 * c + 3] = t4[3];
    }
    unsigned bits = 0;
#pragma unroll
    for (int jj = 0; jj < 4; ++jj) {
      float mine = sv[jj];
#pragma unroll
      for (int c = 1; c < 8; ++c) mine = (sub == c) ? sv[4 * c + jj] : mine;
      const int j = sub * 4 + jj;
      int rank = 0;
#pragma unroll
      for (int k = 0; k < 32; ++k) rank += (sv[k] > mine || (sv[k] == mine && k < j)) ? 1 : 0;
      if (rank < 8 && mine > 0.5f * NEGBIG) bits |= 1u << j;
    }
    bits |= (unsigned)__builtin_amdgcn_mov_dpp((int)bits, 0xB1, 0xF, 0xF, true);
    bits |= (unsigned)__builtin_amdgcn_mov_dpp((int)bits, 0x4E, 0xF, 0xF, true);
    bits |= (unsigned)__builtin_amdgcn_ds_swizzle((int)bits, 0x1F | (4 << 10));
    if (sub == 0) lds_wu(L + NSA_SELM + tok * 4, bits);
  }
  __syncthreads();
  const unsigned selm = lds_ru(L + NSA_SELM + r32 * 4);
  unsigned umask = 0;
  for (int i = 0; i < 32; ++i) umask |= lds_ru(L + NSA_SELM + i * 4);
  __syncthreads();

  const int krow = tid >> 3, kch = (tid & 7) ^ ((tid >> 4) & 7);
  const int vkey = tid >> 2, vc = tid & 3;
#define N_STAGE(kg, vg, buf, j) do { const size_t kb_ = (size_t)(j) * 64; lptr b_ = L + (buf) * NSA_TILE + tid * 16; \
      glds16((kg) + (kb_ + krow) * 64 + kch * 8, b_); glds16((kg) + (kb_ + krow + 32) * 64 + kch * 8, b_ + 4096); \
      glds16((vg) + (kb_ + vkey) * 64 + vc * 8, b_ + 8192); glds16((vg) + (kb_ + vkey) * 64 + 32 + vc * 8, b_ + 12288); } while (0)
#define N_WAIT(more) do { if (more) asm volatile("s_waitcnt vmcnt(4)" ::: "memory"); else asm volatile("s_waitcnt vmcnt(0)" ::: "memory"); __syncthreads(); } while (0)
  f32x16 osel[2];
#pragma unroll
  for (int db = 0; db < 2; ++db)
#pragma unroll
    for (int r = 0; r < 16; ++r) osel[db][r] = 0.f;
  float msel = 0.f, lsel = 0.f;
  {
    const bf16_t* kg = proj + (size_t)(36 + hkv) * SLOT + tokbase * 64;
    const bf16_t* vg = proj + (size_t)(38 + hkv) * SLOT + tokbase * 64;
    auto nextj = [&](int j) { if (j < 0 || j >= 31) return -1; const unsigned rest = umask & ~((2u << j) - 1u); return rest ? (int)__builtin_ctz(rest) : -1; };
    int j0 = __builtin_ctz(umask), j1 = nextj(j0);
    int b0 = 0; bool first = true;
    N_STAGE(kg, vg, 0, j0);
    if (j1 >= 0) N_STAGE(kg, vg, 1, j1);
    N_WAIT(j1 >= 0);
    while (true) {
      const int j2 = nextj(j1);
      const int b2 = b0 == 0 ? 2 : b0 - 1;
      if (j2 >= 0) N_STAGE(kg, vg, b2, j2);
      AdjSel adj{btab + (NSA_M0 - (qpos - j0 * 64 - 4 * hi)) * 4, t0 - (j0 * 64 + 63) >= 128, ((selm >> j0) & 1u) != 0, bfar};
      flash_tile<2>(L + b0 * NSA_TILE, L + b0 * NSA_TILE + 8192, q, osel, msel, lsel, wscr, lane, adj, first);
      first = false;
      N_WAIT(j2 >= 0);
      if (j1 < 0) break;
      j0 = j1; j1 = j2; b0 = b0 == 2 ? 0 : b0 + 1;
    }
  }
  lsel = xor32_sum(lsel);
  if (hi == 0) lds_wf(wscr + 128 + r32 * 4, 1.f / ((1.f + __expf(-gl[1])) * lsel));
#pragma unroll
  for (int r = 0; r < 16; ++r) {
    const float a1 = lds_rf(wscr + hi * 16 + 128 + crow0(r) * 4);
#pragma unroll
    for (int db = 0; db < 2; ++db) { res[db][r] += a1 * osel[db][r]; asm volatile("" : "+v"(res[db][r])); }
  }
  f32x16 owin[2];
#pragma unroll
  for (int db = 0; db < 2; ++db)
#pragma unroll
    for (int r = 0; r < 16; ++r) owin[db][r] = 0.f;
  float mwin = 0.f, lwin = 0.f;
  {
    const bf16_t* kg = proj + (size_t)(40 + hkv) * SLOT + tokbase * 64;
    const bf16_t* vg = proj + (size_t)(42 + hkv) * SLOT + tokbase * 64;
    const int jlo = (t0 - 511) > 0 ? (t0 - 511) >> 6 : 0, jhi = (t0 + 31) >> 6;
    int b0 = 0;
    N_STAGE(kg, vg, 0, jlo);
    if (jlo < jhi) N_STAGE(kg, vg, 1, jlo + 1);
    N_WAIT(jlo < jhi);
    for (int j = jlo; j <= jhi; ++j) {
      const int b2 = b0 == 0 ? 2 : b0 - 1;
      if (j + 2 <= jhi) N_STAGE(kg, vg, b2, j + 2);
      AdjWin adj{btab + (NSA_M0 - (qpos - j * 64 - 4 * hi)) * 4, (t0 - (j * 64 + 63) >= 128) && (t0 + 31 - j * 64 <= 511), bfar};
      flash_tile<2>(L + b0 * NSA_TILE, L + b0 * NSA_TILE + 8192, q, owin, mwin, lwin, wscr, lane, adj, j == jlo);
      N_WAIT(j + 2 <= jhi);
      b0 = b0 == 2 ? 0 : b0 + 1;
    }
  }
#undef N_STAGE
#undef N_WAIT
  lwin = xor32_sum(lwin);
  if (hi == 0) lds_wf(wscr + 128 + r32 * 4, 1.f / ((1.f + __expf(-gl[2])) * lwin));
  bf16_t* op = (bf16_t*)(ws + OFF_ATT) + (tokbase + t0 + 4 * hi) * DM + 512 + hq * 64 + r32;
#pragma unroll
  for (int r = 0; r < 16; ++r) {
    const float a2 = lds_rf(wscr + hi * 16 + 128 + crow0(r) * 4);
#pragma unroll
    for (int db = 0; db < 2; ++db) op[crow0(r) * DM + db * 32] = f2bf(res[db][r] + a2 * owin[db][r]);
  }
  __syncthreads();
}
constexpr int T3_END = 2048;
DI void phase3(const Params& p, lptr L, int wv, int bid, int nb) {
  for (int r = 0; r * nb < T3_END; ++r) {
    const int t = r * nb + ((r & 1) ? nb - 1 - bid : bid);
    if (t >= T3_END) continue;
    const int qt = 63 - (t >> 5), bh = t & 31;
    nsa_task(p, L, wv, bh >> 1, bh & 1, qt, t);
  }
}

constexpr int T4_END = 256 * 8;
DI void phase4(const Params& p, lptr L, int wv, int bid, int nb) {
  char* ws = p.ws;
  for_each_tile_patched(bid, nb, 256, 8, [&](int mt, int nt) {
    EpiResid e{p.x, (bf16_t*)(ws + OFF_STASH)};
    gemm_tile((const bf16_t*)(ws + OFF_ATT), DM, (const bf16_t*)(ws + OFF_WOUTT), DM, DM, mt * 128, nt * 128, L, wv, e);
  });
}
DI void rmsnorm_row_b2b(const bf16_t* __restrict__ xr, const float* __restrict__ g, bf16_t* __restrict__ o, int lane) {
  u32x2 v[4]; float f[16]; float ss = 0.f;
#pragma unroll
  for (int i = 0; i < 4; ++i) { v[i] = *(const u32x2*)(xr + lane * 4 + 256 * i); f[4 * i] = bflo(v[i][0]); f[4 * i + 1] = bfhi(v[i][0]); f[4 * i + 2] = bflo(v[i][1]); f[4 * i + 3] = bfhi(v[i][1]); }
#pragma unroll
  for (int i = 0; i < 16; ++i) ss += f[i] * f[i];
  ss = wave_sum(ss);
  const float rs = rsqrtf(ss * (1.f / 1024.f) + 1e-6f);
#pragma unroll
  for (int i = 0; i < 4; ++i) {
    f32x4 gg = *(const f32x4*)(g + lane * 4 + 256 * i);
    *(u32x2*)(o + lane * 4 + 256 * i) = (u32x2){cvtpk(f[4 * i] * rs * gg[0], f[4 * i + 1] * rs * gg[1]), cvtpk(f[4 * i + 2] * rs * gg[2], f[4 * i + 3] * rs * gg[3])};
  }
}
DI void phase5(const Params& p, lptr L, int wv, int bid, int nb) {
  for (int t = bid; t < NTOK / 4; t += nb) {
    const int tid = task_tid(wv);
    const int row = t * 4 + wv;
    rmsnorm_row_b2b((const bf16_t*)(p.ws + OFF_STASH) + (size_t)row * DM, p.g_ffn, (bf16_t*)(p.ws + OFF_XN) + (size_t)row * DM, tid & 63);
  }
}
constexpr int T6_END = 256 * 16;
DI void phase6(const Params& p, lptr L, int wv, int bid, int nb) {
  char* ws = p.ws;
  for_each_tile_patched(bid, nb, 256, 16, [&](int mt, int nt) {
    EpiBf16 e{(bf16_t*)(ws + OFF_PROJ), 2048, 2048};
    gemm_tile((const bf16_t*)(ws + OFF_XN), DM, (const bf16_t*)(ws + OFF_WPT), DM, DM, mt * 128, nt * 128, L, wv, e);
  });
}

DI unsigned fkey(float f) { unsigned u = __float_as_uint(f); return (u & 0x80000000u) ? ~u : (u | 0x80000000u); }
DI float unfkey(unsigned k) { return __uint_as_float((k & 0x80000000u) ? (k & 0x7fffffffu) : ~k); }
DI void ins16(unsigned (&Lst)[16], unsigned x) {
#pragma unroll
  for (int i = 0; i < 16; ++i) { const unsigned t = Lst[i] > x ? Lst[i] : x; x = Lst[i] > x ? x : Lst[i]; Lst[i] = t; }
}
DI unsigned pack_bf(unsigned s16, int n) {
  const unsigned k = (s16 & 0x8000u) ? (~s16 & 0xffffu) : (s16 | 0x8000u);
  return (k << 16) | (unsigned)(127 - n);
}
DI float unpack_bf(unsigned pk) {
  const unsigned k = pk >> 16;
  const unsigned s = (k & 0x8000u) ? (k & 0x7fffu) : (~k & 0xffffu);
  return __uint_as_float(s << 16);
}
DI void cx_desc(unsigned& hi_, unsigned& lo_) { const unsigned a = hi_ > lo_ ? hi_ : lo_, b = hi_ > lo_ ? lo_ : hi_; hi_ = a; lo_ = b; }
DI void bitonic_merge16_desc(unsigned (&a)[16]) {
#pragma unroll
  for (int j = 8; j > 0; j >>= 1)
#pragma unroll
    for (int i = 0; i < 16; ++i) { const int l = i ^ j; if (l > i) cx_desc(a[i], a[l]); }
}
DI void bitonic_sort16_desc(unsigned (&a)[16]) {
#pragma unroll
  for (int k = 2; k <= 16; k <<= 1)
#pragma unroll
    for (int j = k >> 1; j > 0; j >>= 1)
#pragma unroll
      for (int i = 0; i < 16; ++i) {
        const int l = i ^ j;
        if (l > i) { if ((i & k) == 0) cx_desc(a[i], a[l]); else cx_desc(a[l], a[i]); }
      }
}
DI void cxp_desc(unsigned& kh, unsigned& ph, unsigned& kl, unsigned& pl) {
  const bool gt = kh > kl;
  const unsigned a = gt ? kh : kl, b = gt ? kl : kh, pa = gt ? ph : pl, pb = gt ? pl : ph;
  kh = a; kl = b; ph = pa; pl = pb;
}
DI void bitonic_merge16p_desc(unsigned (&a)[16], unsigned (&q)[16]) {
#pragma unroll
  for (int j = 8; j > 0; j >>= 1)
#pragma unroll
    for (int i = 0; i < 16; ++i) { const int l = i ^ j; if (l > i) cxp_desc(a[i], q[i], a[l], q[l]); }
}
DI void bitonic_sort16p_desc(unsigned (&a)[16], unsigned (&q)[16]) {
#pragma unroll
  for (int k = 2; k <= 16; k <<= 1)
#pragma unroll
    for (int j = k >> 1; j > 0; j >>= 1)
#pragma unroll
      for (int i = 0; i < 16; ++i) {
        const int l = i ^ j;
        if (l > i) { if ((i & k) == 0) cxp_desc(a[i], q[i], a[l], q[l]); else cxp_desc(a[l], q[l], a[i], q[i]); }
      }
}
DI void top16_of_sorted_pair(unsigned (&a)[16], unsigned (&q)[16], const unsigned (&b)[16], const unsigned (&r)[16]) {
#pragma unroll
  for (int i = 0; i < 16; ++i) { const bool gt = a[i] > b[15 - i]; a[i] = gt ? a[i] : b[15 - i]; q[i] = gt ? q[i] : r[15 - i]; }
}
DI void top16_half(const u32x4 (&w)[16], unsigned (&Lst)[16]) {
#pragma unroll
  for (int g = 0; g < 8; ++g) {
    unsigned t[16];
#pragma unroll
    for (int e = 0; e < 4; ++e) {
      t[2 * e] = pack_bf(w[2 * g][e] & 0xffffu, g * 16 + 2 * e); t[2 * e + 1] = pack_bf(w[2 * g][e] >> 16, g * 16 + 2 * e + 1);
      t[8 + 2 * e] = pack_bf(w[2 * g + 1][e] & 0xffffu, g * 16 + 8 + 2 * e); t[8 + 2 * e + 1] = pack_bf(w[2 * g + 1][e] >> 16, g * 16 + 8 + 2 * e + 1);
    }
    bitonic_sort16_desc(t);
    if (g == 0) {
#pragma unroll
      for (int i = 0; i < 16; ++i) Lst[i] = t[i];
    } else {
#pragma unroll
      for (int i = 0; i < 16; ++i) Lst[i] = Lst[i] > t[15 - i] ? Lst[i] : t[15 - i];
      bitonic_merge16_desc(Lst);
    }
    __builtin_amdgcn_sched_barrier(0);
  }
}
DI void phase7(const Params& p, lptr L, int wv, int bid, int nb) {
  char* ws = p.ws;
  const int tid = task_tid(wv);
  const bf16_t* S = (const bf16_t*)(ws + OFF_PROJ);
  int* E = (int*)(ws + OFF_PEER_E); float* G = (float*)(ws + OFF_PEER_G);
  for (int task = bid * 256 + tid; task < NTOK * 8; task += nb * 256) {
    const bf16_t* srow = S + (size_t)task * 256;
    u32x4 wa[16], wb[16];
#pragma unroll
    for (int c = 0; c < 16; ++c) { wa[c] = *(const u32x4*)(srow + c * 8); wb[c] = *(const u32x4*)(srow + 128 + c * 8); }
    unsigned A[16], B[16];
    top16_half(wa, A);
    top16_half(wb, B);
    float av[16], bv[16];
#pragma unroll
    for (int i = 0; i < 16; ++i) { av[i] = unpack_bf(A[i]); bv[i] = unpack_bf(B[i]); }
#define CAND_K(i, j) ((fkey(av[i] + bv[j]) & 0xffffff00u) | (unsigned)(255 - ((i) * 16 + (j))))
#define CAND_P(i, j) ((127u - (A[i] & 127u)) * 128u + (127u - (B[j] & 127u)))
    unsigned CK[16], CP[16], DK[16], DP[16];
#pragma unroll
    for (int j = 0; j < 16; ++j) { CK[j] = CAND_K(0, j); CP[j] = CAND_P(0, j); }
    bitonic_sort16p_desc(CK, CP);
#pragma unroll
    for (int j = 0; j < 8; ++j) { DK[j] = CAND_K(1, j); DP[j] = CAND_P(1, j); }
#pragma unroll
    for (int j = 0; j < 5; ++j) { DK[8 + j] = CAND_K(2, j); DP[8 + j] = CAND_P(2, j); }
#pragma unroll
    for (int j = 0; j < 3; ++j) { DK[13 + j] = CAND_K(3, j); DP[13 + j] = CAND_P(3, j); }
    bitonic_sort16p_desc(DK, DP);
    top16_of_sorted_pair(CK, CP, DK, DP);
    bitonic_merge16p_desc(CK, CP);
    DK[0] = CAND_K(3, 3); DP[0] = CAND_P(3, 3);
#pragma unroll
    for (int j = 0; j < 3; ++j) { DK[1 + j] = CAND_K(4, j); DP[1 + j] = CAND_P(4, j); }
#pragma unroll
    for (int i = 5; i < 8; ++i) { DK[4 + 2 * (i - 5)] = CAND_K(i, 0); DP[4 + 2 * (i - 5)] = CAND_P(i, 0); DK[5 + 2 * (i - 5)] = CAND_K(i, 1); DP[5 + 2 * (i - 5)] = CAND_P(i, 1); }
#pragma unroll
    for (int i = 8; i < 14; ++i) { DK[10 + (i - 8)] = CAND_K(i, 0); DP[10 + (i - 8)] = CAND_P(i, 0); }
    bitonic_sort16p_desc(DK, DP);
#pragma unroll
    for (int i = 14; i < 16; ++i) {
      unsigned k = CAND_K(i, 0), pl = CAND_P(i, 0);
#pragma unroll
      for (int s2 = 0; s2 < 16; ++s2) cxp_desc(DK[s2], DP[s2], k, pl);
    }
    top16_of_sorted_pair(CK, CP, DK, DP);
#undef CAND_K
#undef CAND_P
    float cv[16], sm = 0.f;
    unsigned kmax = CK[0];
#pragma unroll
    for (int i = 1; i < 16; ++i) kmax = kmax > CK[i] ? kmax : CK[i];
    const float mx = unfkey(kmax & 0xffffff00u);
#pragma unroll
    for (int i = 0; i < 16; ++i) { cv[i] = __expf(unfkey(CK[i] & 0xffffff00u) - mx); sm += cv[i]; }
    const float inv = 1.f / sm;
    int* eo = E + (size_t)task * 16; float* go = G + (size_t)task * 16;
#pragma unroll
    for (int i = 0; i < 4; ++i) {
      *(u32x4*)(eo + 4 * i) = (u32x4){CP[4 * i], CP[4 * i + 1], CP[4 * i + 2], CP[4 * i + 3]};
      *(f32x4*)(go + 4 * i) = (f32x4){cv[4 * i] * inv, cv[4 * i + 1] * inv, cv[4 * i + 2] * inv, cv[4 * i + 3] * inv};
    }
  }
}

DI void dec16(const u32x2& w, float (&f)[16]) {
#pragma unroll
  for (int d = 0; d < 2; ++d) {
    const f32v2_t a = __builtin_amdgcn_cvt_scalef32_pk_f32_fp4(w[d], 1.0f, 0), b = __builtin_amdgcn_cvt_scalef32_pk_f32_fp4(w[d], 1.0f, 1);
    const f32v2_t c = __builtin_amdgcn_cvt_scalef32_pk_f32_fp4(w[d], 1.0f, 2), e = __builtin_amdgcn_cvt_scalef32_pk_f32_fp4(w[d], 1.0f, 3);
    f[8 * d] = a[0]; f[8 * d + 1] = a[1]; f[8 * d + 2] = b[0]; f[8 * d + 3] = b[1];
    f[8 * d + 4] = c[0]; f[8 * d + 5] = c[1]; f[8 * d + 6] = e[0]; f[8 * d + 7] = e[1];
  }
}
DI void phase8(const Params& p, lptr L, int wv, int bid, int nb, float* dst) {
  char* ws = p.ws;
  const int tid = task_tid(wv), lane = tid & 63, w = wv;
  const auto rsU = __builtin_amdgcn_make_buffer_rsrc((void*)(ws + OFF_U), 0, 8 << 20, 0x00020000);
  const auto rsV = __builtin_amdgcn_make_buffer_rsrc((void*)(ws + OFF_V), 0, 8 << 20, 0x00020000);
  const float* SU = (const float*)(ws + OFF_U + 16 * MiB); const float* SV = (const float*)(ws + OFF_V + 16 * MiB);
  const int* E = (const int*)(ws + OFF_PEER_E); const float* G = (const float*)(ws + OFF_PEER_G);
  for (int tok = bid * 4 + w; tok < NTOK; tok += nb * 4) {
    const bf16_t* xr = (const bf16_t*)(ws + OFF_XN) + (size_t)tok * DM + lane * 4;
    float xa[16];
#pragma unroll
    for (int i = 0; i < 4; ++i) { const u32x2 a = *(const u32x2*)(xr + 256 * i); xa[4 * i] = bflo(a[0]); xa[4 * i + 1] = bfhi(a[0]); xa[4 * i + 2] = bflo(a[1]); xa[4 * i + 3] = bfhi(a[1]); }
    float acc[16];
#pragma unroll
    for (int i = 0; i < 16; ++i) acc[i] = 0.f;
    const int e_lo = E[(size_t)tok * 128 + lane], e_hi = E[(size_t)tok * 128 + 64 + lane];
    const float g_lo = G[(size_t)tok * 128 + lane], g_hi = G[(size_t)tok * 128 + 64 + lane];
    const float su_lo = SU[e_lo], su_hi = SU[e_hi], sv_lo = SV[e_lo], sv_hi = SV[e_hi];
#pragma unroll 1
    for (int hb = 0; hb < 8; ++hb) {
      const int e = (hb & 4) ? e_hi : e_lo;
      const int l0 = (hb & 3) * 16;
      u32x2 ur[16], vr[16];
#pragma unroll
      for (int k = 0; k < 16; ++k) { const int ek = __builtin_amdgcn_readlane(e, l0 + k); ur[k] = __builtin_amdgcn_raw_buffer_load_b64(rsU, lane * 8, ek * 512, PEER_AUX); }
#pragma unroll
      for (int k = 0; k < 16; ++k) { const int ek = __builtin_amdgcn_readlane(e, l0 + k); vr[k] = __builtin_amdgcn_raw_buffer_load_b64(rsV, lane * 8, ek * 512, PEER_AUX); }
      const int src = (l0 + (lane >> 2)) * 4;
      const float gk = __uint_as_float(__builtin_amdgcn_ds_bpermute(src, __float_as_uint((hb & 4) ? g_hi : g_lo)));
      const float suk = __uint_as_float(__builtin_amdgcn_ds_bpermute(src, __float_as_uint((hb & 4) ? su_hi : su_lo)));
      const float svk = __uint_as_float(__builtin_amdgcn_ds_bpermute(src, __float_as_uint((hb & 4) ? sv_hi : sv_lo)));
      __builtin_amdgcn_sched_barrier(0);
      float dp[16];
#pragma unroll
      for (int k = 0; k < 16; ++k) {
        float f[16]; dec16(ur[k], f);
        float s0 = 0.f, s1 = 0.f;
#pragma unroll
        for (int i = 0; i < 8; ++i) { s0 += xa[2 * i] * f[2 * i]; s1 += xa[2 * i + 1] * f[2 * i + 1]; }
        dp[k] = s0 + s1;
      }
      __builtin_amdgcn_sched_barrier(0);
      float t8[8], t4[4], t2[2], z;
      { const bool b = (lane & 32) != 0;
#pragma unroll
        for (int i = 0; i < 8; ++i) { const float snd = b ? dp[i] : dp[i + 8], kp = b ? dp[i + 8] : dp[i]; t8[i] = kp + __shfl_xor(snd, 32); } }
      { const bool b = (lane & 16) != 0;
#pragma unroll
        for (int i = 0; i < 4; ++i) { const float snd = b ? t8[i] : t8[i + 4], kp = b ? t8[i + 4] : t8[i]; t4[i] = kp + __shfl_xor(snd, 16); } }
      { const bool b = (lane & 8) != 0;
#pragma unroll
        for (int i = 0; i < 2; ++i) { const float snd = b ? t4[i] : t4[i + 2], kp = b ? t4[i + 2] : t4[i]; t2[i] = kp + __shfl_xor(snd, 8); } }
      { const bool b = (lane & 4) != 0; const float snd = b ? t2[0] : t2[1], kp = b ? t2[1] : t2[0]; z = kp + __shfl_xor(snd, 4); }
      z += __shfl_xor(z, 2); z += __shfl_xor(z, 1);
      const float wgt = gk * gelu_tanh(z * suk) * svk;
      __builtin_amdgcn_sched_barrier(0);
#pragma unroll
      for (int k = 0; k < 16; ++k) {
        const float wk = __uint_as_float(__builtin_amdgcn_readlane(__float_as_uint(wgt), 4 * k));
        float f[16]; dec16(vr[k], f);
#pragma unroll
        for (int i = 0; i < 16; ++i) acc[i] += wk * f[i];
      }
    }
    const bf16_t* orow = (const bf16_t*)(ws + OFF_STASH) + (size_t)tok * DM + lane * 4;
    float* drow = dst + (size_t)tok * DM + lane * 4;
    float ss = 0.f;
#pragma unroll
    for (int i = 0; i < 4; ++i) {
      const u32x2 ab = *(const u32x2*)(orow + 256 * i);
      const f32x4 a = {bflo(ab[0]), bfhi(ab[0]), bflo(ab[1]), bfhi(ab[1])};
#pragma unroll
      for (int k = 0; k < 4; ++k) { acc[4 * i + k] += a[k]; ss += acc[4 * i + k] * acc[4 * i + k]; }
    }
    ss = wave_sum(ss);
    const float rs = rsqrtf(ss * (1.f / 1024.f) + 1e-6f);
    const float* gf = p.g_fin + lane * 4;
#pragma unroll
    for (int i = 0; i < 4; ++i) {
      f32x4 gg = *(const f32x4*)(gf + 256 * i), a;
#pragma unroll
      for (int k = 0; k < 4; ++k) a[k] = acc[4 * i + k] * rs * gg[k];
      *(f32x4*)(drow + 256 * i) = a;
    }
  }
}

#define XB_TMO      128
#define XB_XCNT(j)  (256  + 64 * (j))
#define XB_XSUB(j)  (1280 + 64 * (j))
#define XB_XGEN(j)  (2304 + 64 * (j))
#define XB_TOP      3328
#define XB_TOPGEN   3392
#define XCD_BAR_WORDS 3456
#define XB_SPIN_CAP (1u << 22)
#define LAS __attribute__((address_space(3)))
DI unsigned xb_ld(unsigned* p)              { return __hip_atomic_load(p, __ATOMIC_RELAXED, __HIP_MEMORY_SCOPE_AGENT); }
DI unsigned xb_add(unsigned* p, unsigned v) { return __hip_atomic_fetch_add(p, v, __ATOMIC_RELAXED, __HIP_MEMORY_SCOPE_AGENT); }
DI unsigned xb_xcc_id() { return (unsigned)__builtin_amdgcn_s_getreg((3 << 11) | 20) & 0xFu; }
#define XB_SPIN(cond, bar) do { unsigned _sp = 0; while (cond) { __builtin_amdgcn_s_sleep(1); \
    if ((++_sp & 255u) == 0u) { if (xb_ld(&(bar)[XB_TMO])) break; if (_sp > XB_SPIN_CAP) { atomicAdd(&(bar)[XB_TMO], 1u); break; } } } } while (0)
struct XcdBarrier { unsigned* bar; unsigned x; volatile LAS unsigned* st; };
DI XcdBarrier xcd_barrier_post(unsigned* bar, volatile LAS unsigned* st) {
  XcdBarrier b; b.bar = bar; b.x = xb_xcc_id(); b.st = st;
  if (threadIdx.x == 0) (void)xb_add(&bar[XB_XCNT(b.x)], 1u);
  return b;
}
DI void xcd_barrier_complete(unsigned* bar, unsigned x, unsigned& nloc, unsigned& nx) {
  const unsigned G = gridDim.x * gridDim.y * gridDim.z;
  unsigned sum, cnt, mine, sp = 0u;
  for (;;) {
    sum = 0u; cnt = 0u; mine = 0u;
#pragma unroll
    for (unsigned j = 0; j < 16; ++j) { const unsigned c = xb_ld(&bar[XB_XCNT(j)]); sum += c; cnt += (c > 0u) ? 1u : 0u; mine = (j == x) ? c : mine; }
    if (sum == G) break;
    __builtin_amdgcn_s_sleep(1);
    if ((++sp & 255u) == 0u) { if (xb_ld(&bar[XB_TMO])) break; if (sp > XB_SPIN_CAP) { atomicAdd(&bar[XB_TMO], 1u); break; } }
  }
  nloc = mine > 0u ? mine : 1u; nx = cnt > 0u ? cnt : 1u;
}
DI void xcd_barrier(const XcdBarrier& b) {
  asm volatile("s_waitcnt vmcnt(0)" ::: "memory");
  __syncthreads();
  if (threadIdx.x == 0) {
    unsigned* bar = b.bar;
    __builtin_amdgcn_s_waitcnt(0);
    unsigned nloc = b.st[0], nx = b.st[1];
    if (nloc == 0u) { xcd_barrier_complete(bar, b.x, nloc, nx); b.st[0] = nloc; b.st[1] = nx; }
    const unsigned old = xb_add(&bar[XB_XSUB(b.x)], 1u);
    const unsigned gen = old / nloc;
    if (old + 1u == (gen + 1u) * nloc) {
      __builtin_amdgcn_fence(__ATOMIC_RELEASE, "agent");
      asm volatile("s_waitcnt vmcnt(0)" ::: "memory");
      const unsigned og = xb_add(&bar[XB_TOP], 1u);
      const unsigned tg = og / nx;
      if (og + 1u == (tg + 1u) * nx) xb_add(&bar[XB_TOPGEN], 1u);
      else XB_SPIN(xb_ld(&bar[XB_TOPGEN]) == tg, bar);
      __builtin_amdgcn_fence(__ATOMIC_ACQUIRE, "agent");
      xb_add(&bar[XB_XGEN(b.x)], 1u);
      asm volatile("s_waitcnt vmcnt(0)" ::: "memory");
    } else {
      XB_SPIN(xb_ld(&bar[XB_XGEN(b.x)]) == gen, bar);
      __builtin_amdgcn_fence(__ATOMIC_ACQUIRE, "agent");
      asm volatile("s_waitcnt vmcnt(0)" ::: "memory");
    }
  }
  __syncthreads();
}

#if !MEGA
#define PHASE_KERNEL(name, fn) \
  __global__ void __launch_bounds__(256, 2) name(Params p) { \
    __shared__ __attribute__((aligned(16))) char lds_[LDS_BYTES]; \
    fn(p, (lptr)lds_, __builtin_amdgcn_readfirstlane(threadIdx.x >> 6), blockIdx.x, gridDim.x); }
PHASE_KERNEL(k_phase0, phase0)
PHASE_KERNEL(k_phase1, phase1)
PHASE_KERNEL(k_phase2, phase2)
PHASE_KERNEL(k_phase2b, phase2b)
PHASE_KERNEL(k_phase3, phase3)
PHASE_KERNEL(k_phase4, phase4)
PHASE_KERNEL(k_phase5, phase5)
PHASE_KERNEL(k_phase6, phase6)
PHASE_KERNEL(k_phase7, phase7)
__global__ void __launch_bounds__(256, 2) k_phase8(Params p) {
  __shared__ __attribute__((aligned(16))) char lds_[LDS_BYTES];
  phase8(p, (lptr)lds_, __builtin_amdgcn_readfirstlane(threadIdx.x >> 6), blockIdx.x, gridDim.x, p.out); }

__global__ void k_dbg_att(Params p) {
  const bf16_t* a = (const bf16_t*)(p.ws + OFF_ATT);
  for (size_t i = (size_t)blockIdx.x * 256 + threadIdx.x; i < (size_t)NTOK * DM; i += (size_t)gridDim.x * 256) p.out[i] = bf2f(a[i]);
}
#endif
#if MEGA
__global__ void __launch_bounds__(256, 2) k_mega(Params p) {
  __shared__ __attribute__((aligned(16))) char lds_[LDS_BYTES];
  cg::grid_group grid = cg::this_grid();
  lptr L = (lptr)lds_;
  const int bid = blockIdx.x, nb = gridDim.x, wv = __builtin_amdgcn_readfirstlane(threadIdx.x >> 6);
  volatile LAS unsigned* bst = (volatile LAS unsigned*)(L + LDS_BYTES - 16);
  if (threadIdx.x == 0) { bst[0] = 0u; bst[1] = 0u; bst[2] = 0u; bst[3] = 0u; }
  __syncthreads();
  const XcdBarrier xb = xcd_barrier_post((unsigned*)(p.ws + OFF_BAR), bst);
#define GSYNC() xcd_barrier(xb)
  if (p.ws == nullptr) grid.sync();
  phase0(p, L, wv, bid, nb); GSYNC();
#if DUP == 0
  phase0(p, L, wv, bid, nb); GSYNC();
#endif
  phase1(p, L, wv, bid, nb); GSYNC();
#if DUP == 1
  phase1(p, L, wv, bid, nb); GSYNC();
#endif
  phase2(p, L, wv, bid, nb); GSYNC();
#if DUP == 2
  phase2(p, L, wv, bid, nb); GSYNC();
#endif
  phase2b(p, L, wv, bid, nb); GSYNC();
  phase3(p, L, wv, bid, nb); GSYNC();
#if DUP == 3
  phase3(p, L, wv, bid, nb); GSYNC();
#endif
  phase4(p, L, wv, bid, nb); GSYNC();
#if DUP == 4
  phase4(p, L, wv, bid, nb); GSYNC();
#endif
  phase5(p, L, wv, bid, nb); GSYNC();
#if DUP == 5
  phase5(p, L, wv, bid, nb); GSYNC();
#endif
  phase6(p, L, wv, bid, nb); GSYNC();
#if DUP == 6
  phase6(p, L, wv, bid, nb); GSYNC();
#endif
  phase7(p, L, wv, bid, nb); GSYNC();
#if DUP == 7
  phase7(p, L, wv, bid, nb); GSYNC();
#endif
#if DUP == 8
  phase8(p, L, wv, bid, nb, (float*)(p.ws + OFF_PROJ)); GSYNC();
#endif
  phase8(p, L, wv, bid, nb, p.out);
}
#endif

extern "C" void kernel_launch(void* const* d_in, const int* in_sizes, int n_in, void* d_out, int out_size, void* d_ws, size_t ws_size, hipStream_t stream) {
  Params p{};
  const float** pp = (const float**)&p;
  for (int i = 0; i < 22; ++i) pp[i] = (const float*)d_in[i];
  p.out = (float*)d_out;
  p.ws = (char*)d_ws;
  if (ws_size < OFF_END) { fprintf(stderr, "kernel_launch: workspace too small (%zu < %zu)\n", ws_size, (size_t)OFF_END); return; }
#if MEGA
  static int grid_blocks = 0;
  if (!grid_blocks) {
    int dev = 0, cus = 0, per_cu = 0;
    hipGetDevice(&dev);
    hipDeviceGetAttribute(&cus, hipDeviceAttributeMultiprocessorCount, dev);
    hipOccupancyMaxActiveBlocksPerMultiprocessor(&per_cu, k_mega, 256, 0);
    if (per_cu > 2) per_cu = 2;
    if (per_cu < 1) per_cu = 1;
    grid_blocks = cus * per_cu;
  }
  hipMemsetAsync((char*)d_ws + OFF_BAR, 0, XCD_BAR_WORDS * 4, stream);
  void* args[] = {&p};
  hipError_t e = hipLaunchCooperativeKernel((void*)k_mega, dim3(grid_blocks), dim3(256), args, 0, stream);
  if (e != hipSuccess) fprintf(stderr, "cooperative launch failed: %s (grid %d)\n", hipGetErrorString(e), grid_blocks);
#else
  const int G = 1024;
#if DBG == 1
  k_phase0<<<G, 256, 0, stream>>>(p);
  k_phase1<<<G, 256, 0, stream>>>(p);
  k_phase2<<<G, 256, 0, stream>>>(p);
  k_phase2b<<<64, 256, 0, stream>>>(p);
  k_phase3<<<G, 256, 0, stream>>>(p);
  k_dbg_att<<<G, 256, 0, stream>>>(p);
  return;
#endif
  k_phase0<<<G, 256, 0, stream>>>(p);
  k_phase1<<<G, 256, 0, stream>>>(p);
  k_phase2<<<G, 256, 0, stream>>>(p);
  k_phase2b<<<64, 256, 0, stream>>>(p);
  k_phase3<<<G, 256, 0, stream>>>(p);
  k_phase4<<<G, 256, 0, stream>>>(p);
  k_phase5<<<G, 256, 0, stream>>>(p);
  k_phase6<<<G, 256, 0, stream>>>(p);
  k_phase7<<<G, 256, 0, stream>>>(p);
  k_phase8<<<G, 256, 0, stream>>>(p);
#endif
}
```

```cpp
#include <hip/hip_runtime.h>
#include <hip/hip_cooperative_groups.h>
#include <stdint.h>
#include <stdio.h>
namespace cg = cooperative_groups;

#ifndef MEGA
#define MEGA 1
#endif
#ifndef DBG
#define DBG 0
#endif
#ifndef PEER_AUX
#define PEER_AUX 0
#endif
#ifndef DUP
#define DUP -1
#endif

#define DI __device__ __forceinline__
typedef unsigned short bf16_t;
typedef __attribute__((ext_vector_type(8))) short bf16x8;
typedef __attribute__((ext_vector_type(4))) short s16x4;
typedef __attribute__((ext_vector_type(16))) float f32x16;
typedef __attribute__((ext_vector_type(4))) float f32x4;
typedef __attribute__((ext_vector_type(4))) unsigned u32x4;
typedef __attribute__((ext_vector_type(2))) unsigned u32x2;
typedef __attribute__((address_space(3))) char* lptr;
typedef const __attribute__((address_space(3))) char* lcptr;
typedef short v4i16_t __attribute__((ext_vector_type(4)));

constexpr int NTOK = 32768, DM = 1024, SEQ = 2048, NBATCH = 16;
constexpr size_t SLOT = (size_t)NTOK * 64;
constexpr float LOG2E = 1.4426950408889634f;
constexpr float QSCALE = 0.125f * LOG2E;
constexpr float NEGBIG = -1e30f;
constexpr float RTHR = 8.0f;
constexpr int LDS_BYTES = 73728;

constexpr size_t MiB = (size_t)1 << 20;
constexpr size_t OFF_XN = 0;
constexpr size_t OFF_PROJ = 64 * MiB;
constexpr size_t OFF_GATES = OFF_PROJ + 180 * MiB;
constexpr size_t OFF_ATT = OFF_GATES + 4 * MiB;
constexpr size_t OFF_WINT = OFF_ATT + 64 * MiB;
constexpr size_t OFF_WOUTT = OFF_WINT + 6 * MiB;
constexpr size_t OFF_WQB = OFF_WOUTT + 2 * MiB;
constexpr size_t OFF_SUBK = OFF_WQB + 4 * MiB;
constexpr size_t OFF_WPT = OFF_SUBK + 1 * MiB;
constexpr size_t OFF_U = OFF_WPT + 4 * MiB;
constexpr size_t OFF_V = OFF_U + 32 * MiB;
constexpr size_t OFF_W1KT = OFF_V + 32 * MiB;
constexpr size_t OFF_W1VT = OFF_W1KT + 1 * MiB;
constexpr size_t OFF_W2KT = OFF_W1VT + 1 * MiB;
constexpr size_t OFF_W2VT = OFF_W2KT + 64 * 1024;
constexpr size_t OFF_MISC = OFF_W2VT + 64 * 1024;
constexpr size_t OFF_HID = OFF_MISC + 64 * 1024;
constexpr size_t OFF_KCMP = OFF_HID + 4 * MiB;
constexpr size_t OFF_STASH = OFF_KCMP + 1 * MiB;
constexpr size_t OFF_BAR = OFF_STASH + 64 * MiB;
constexpr size_t OFF_END = OFF_BAR + 64 * 1024;
constexpr size_t OFF_PEER_E = OFF_ATT;
constexpr size_t OFF_PEER_G = OFF_ATT + 16 * MiB;

struct Params {
  const float *x, *w_in, *w_out, *g_mix, *g_ffn, *g_fin, *rel_bias, *lq1, *lk1, *lq2, *lk2, *subln;
  const float *pos_k, *pos_v, *w1k, *w2k, *w1v, *w2v, *wq, *subk, *pu, *pv;
  float* out;
  char* ws;
};

DI int crow(int r, int hi) { return (r & 3) + 8 * (r >> 2) + 4 * hi; }
DI constexpr int crow0(int r) { return (r & 3) + 8 * (r >> 2); }
typedef __bf16 bf16v2_t __attribute__((ext_vector_type(2)));
typedef float f32v2_t __attribute__((ext_vector_type(2)));
DI unsigned cvtpk(float lo, float hi) { return __builtin_bit_cast(unsigned, __builtin_convertvector((f32v2_t){lo, hi}, bf16v2_t)); }
DI bf16_t f2bf(float x) { return (bf16_t)(cvtpk(x, 0.f) & 0xffffu); }
DI float bf2f(bf16_t b) { return __uint_as_float((unsigned)b << 16); }
DI float bflo(unsigned w) { return __uint_as_float(w << 16); }
DI float bfhi(unsigned w) { return __uint_as_float(w & 0xffff0000u); }
#define MFMA32(a, b, c) __builtin_amdgcn_mfma_f32_32x32x16_bf16((a), (b), (c), 0, 0, 0)
DI bf16x8 lds_r128(lcptr p) { return *(const __attribute__((address_space(3))) bf16x8*)p; }
DI void lds_w128(lptr p, u32x4 v) { *(__attribute__((address_space(3))) u32x4*)p = v; }
DI float lds_rf(lcptr p) { return *(const __attribute__((address_space(3))) float*)p; }
DI void lds_wf(lptr p, float v) { *(__attribute__((address_space(3))) float*)p = v; }
DI unsigned lds_ru(lcptr p) { return *(const __attribute__((address_space(3))) unsigned*)p; }
DI void lds_wu(lptr p, unsigned v) { *(__attribute__((address_space(3))) unsigned*)p = v; }
DI s16x4 vtr(lcptr p) { return __builtin_bit_cast(s16x4, __builtin_amdgcn_ds_read_tr16_b64_v4i16((__attribute__((address_space(3))) v4i16_t*)p)); }
DI float wave_sum(float v) {
#pragma unroll
  for (int o = 32; o > 0; o >>= 1) v += __shfl_xor(v, o);
  return v;
}
DI float xor32_max(float m) { auto rr = __builtin_amdgcn_permlane32_swap(__float_as_uint(m), __float_as_uint(m), false, false); return fmaxf(__uint_as_float(rr[0]), __uint_as_float(rr[1])); }
DI float xor32_sum(float m) { auto rr = __builtin_amdgcn_permlane32_swap(__float_as_uint(m), __float_as_uint(m), false, false); return __uint_as_float(rr[0]) + __uint_as_float(rr[1]); }
DI float gelu_tanh(float x) { float y = 1.5957691216057308f * (x + 0.044715f * x * x * x); return x / (1.f + __expf(-y)); }
DI int lane_id() { return __builtin_amdgcn_mbcnt_hi(~0u, __builtin_amdgcn_mbcnt_lo(~0u, 0)); }
DI int task_tid(int wv) { int l; asm volatile("v_mbcnt_lo_u32_b32 %0, -1, 0\n\tv_mbcnt_hi_u32_b32 %0, -1, %0" : "=v"(l)); return wv * 64 + l; }
DI int mbcnt64(unsigned long long m) { return __builtin_amdgcn_mbcnt_hi((unsigned)(m >> 32), __builtin_amdgcn_mbcnt_lo((unsigned)m, 0)); }

DI void transpose_tile(const float* __restrict__ in, int N, bf16_t* __restrict__ out, int K, int tk, int tn, lptr L, int tid) {
#pragma unroll
  for (int i = 0; i < 16; ++i) {
    int e = tid + 256 * i, kk = e >> 6, nn = e & 63, n = tn * 64 + nn;
    float v = (n < N) ? in[(size_t)(tk * 64 + kk) * N + n] : 0.f;
    lds_wf(L + (kk * 65 + nn) * 4, v);
  }
  __syncthreads();
  const int nn = tid >> 2, kc = (tid & 3) * 16;
  unsigned w[8];
#pragma unroll
  for (int i = 0; i < 8; ++i) w[i] = cvtpk(lds_rf(L + ((kc + 2 * i) * 65 + nn) * 4), lds_rf(L + ((kc + 2 * i + 1) * 65 + nn) * 4));
  bf16_t* o = out + (size_t)(tn * 64 + nn) * K + tk * 64 + kc;
  *(u32x4*)o = (u32x4){w[0], w[1], w[2], w[3]};
  *(u32x4*)(o + 8) = (u32x4){w[4], w[5], w[6], w[7]};
  __syncthreads();
}
DI void convert_chunk(const float* __restrict__ in, bf16_t* __restrict__ out, size_t chunk, int tid) {
  size_t i = chunk * 2048 + (size_t)tid * 8;
  f32x4 a = *(const f32x4*)(in + i), b = *(const f32x4*)(in + i + 4);
  *(u32x4*)(out + i) = (u32x4){cvtpk(a[0], a[1]), cvtpk(a[2], a[3]), cvtpk(b[0], b[1]), cvtpk(b[2], b[3])};
}
DI void rmsnorm_rows4_bf16(const float* __restrict__ x0, const float* __restrict__ g, bf16_t* __restrict__ o0, int lane) {
  f32x4 v[4][4];
#pragma unroll
  for (int j = 0; j < 4; ++j)
#pragma unroll
    for (int i = 0; i < 4; ++i) v[j][i] = *(const f32x4*)(x0 + (size_t)j * DM + lane * 4 + 256 * i);
  f32x4 gg[4];
#pragma unroll
  for (int i = 0; i < 4; ++i) gg[i] = *(const f32x4*)(g + lane * 4 + 256 * i);
#pragma unroll
  for (int j = 0; j < 4; ++j) {
    float ss = 0.f;
#pragma unroll
    for (int i = 0; i < 4; ++i) ss += v[j][i][0] * v[j][i][0] + v[j][i][1] * v[j][i][1] + v[j][i][2] * v[j][i][2] + v[j][i][3] * v[j][i][3];
    ss = wave_sum(ss);
    const float rs = rsqrtf(ss * (1.f / 1024.f) + 1e-6f);
#pragma unroll
    for (int i = 0; i < 4; ++i)
      *(u32x2*)(o0 + (size_t)j * DM + lane * 4 + 256 * i) = (u32x2){cvtpk(v[j][i][0] * rs * gg[i][0], v[j][i][1] * rs * gg[i][1]), cvtpk(v[j][i][2] * rs * gg[i][2], v[j][i][3] * rs * gg[i][3])};
  }
}
DI void rmsnorm_row_bf16(const float* __restrict__ xr, const float* __restrict__ g, bf16_t* __restrict__ o, int lane) {
  f32x4 v[4]; float ss = 0.f;
#pragma unroll
  for (int i = 0; i < 4; ++i) { v[i] = *(const f32x4*)(xr + lane * 4 + 256 * i); ss += v[i][0] * v[i][0] + v[i][1] * v[i][1] + v[i][2] * v[i][2] + v[i][3] * v[i][3]; }
  ss = wave_sum(ss);
  const float rs = rsqrtf(ss * (1.f / 1024.f) + 1e-6f);
#pragma unroll
  for (int i = 0; i < 4; ++i) {
    f32x4 gg = *(const f32x4*)(g + lane * 4 + 256 * i);
    *(u32x2*)(o + lane * 4 + 256 * i) = (u32x2){cvtpk(v[i][0] * rs * gg[0], v[i][1] * rs * gg[1]), cvtpk(v[i][2] * rs * gg[2], v[i][3] * rs * gg[3])};
  }
}
DI void quant_row_fp4(const float* __restrict__ in, char* __restrict__ base, int row, int lane) {
  const float* r = in + (size_t)row * DM + lane * 4;
  f32x4 v[4]; float m = 0.f;
#pragma unroll
  for (int i = 0; i < 4; ++i) { v[i] = *(const f32x4*)(r + 256 * i); m = fmaxf(m, fmaxf(fmaxf(fabsf(v[i][0]), fabsf(v[i][1])), fmaxf(fabsf(v[i][2]), fabsf(v[i][3])))); }
#pragma unroll
  for (int o = 32; o > 0; o >>= 1) m = fmaxf(m, __shfl_xor(m, o));
  m = fmaxf(m, 1e-30f);
  const float sc = 6.f / m;
  unsigned w0 = 0u, w1 = 0u;
  w0 = __builtin_amdgcn_cvt_scalef32_pk_fp4_f32(w0, v[0][0] * sc, v[0][1] * sc, 1.0f, 0);
  w0 = __builtin_amdgcn_cvt_scalef32_pk_fp4_f32(w0, v[0][2] * sc, v[0][3] * sc, 1.0f, 1);
  w0 = __builtin_amdgcn_cvt_scalef32_pk_fp4_f32(w0, v[1][0] * sc, v[1][1] * sc, 1.0f, 2);
  w0 = __builtin_amdgcn_cvt_scalef32_pk_fp4_f32(w0, v[1][2] * sc, v[1][3] * sc, 1.0f, 3);
  w1 = __builtin_amdgcn_cvt_scalef32_pk_fp4_f32(w1, v[2][0] * sc, v[2][1] * sc, 1.0f, 0);
  w1 = __builtin_amdgcn_cvt_scalef32_pk_fp4_f32(w1, v[2][2] * sc, v[2][3] * sc, 1.0f, 1);
  w1 = __builtin_amdgcn_cvt_scalef32_pk_fp4_f32(w1, v[3][0] * sc, v[3][1] * sc, 1.0f, 2);
  w1 = __builtin_amdgcn_cvt_scalef32_pk_fp4_f32(w1, v[3][2] * sc, v[3][3] * sc, 1.0f, 3);
  *(u32x2*)(base + (size_t)row * 512 + lane * 8) = (u32x2){w0, w1};
  if (lane == 0) ((float*)(base + 16 * MiB))[row] = m * (1.f / 6.f);
}
DI void quant_rows4_fp4(const float* __restrict__ in, char* __restrict__ base, int row0, int lane) {
  f32x4 v[4][4];
#pragma unroll
  for (int j = 0; j < 4; ++j)
#pragma unroll
    for (int i = 0; i < 4; ++i) v[j][i] = *(const f32x4*)(in + (size_t)(row0 + j) * DM + lane * 4 + 256 * i);
#pragma unroll
  for (int j = 0; j < 4; ++j) {
    float m = 0.f;
#pragma unroll
    for (int i = 0; i < 4; ++i) m = fmaxf(m, fmaxf(fmaxf(fabsf(v[j][i][0]), fabsf(v[j][i][1])), fmaxf(fabsf(v[j][i][2]), fabsf(v[j][i][3]))));
#pragma unroll
    for (int o = 32; o > 0; o >>= 1) m = fmaxf(m, __shfl_xor(m, o));
    m = fmaxf(m, 1e-30f);
    const float sc = 6.f / m;
    unsigned w0 = 0u, w1 = 0u;
    w0 = __builtin_amdgcn_cvt_scalef32_pk_fp4_f32(w0, v[j][0][0] * sc, v[j][0][1] * sc, 1.0f, 0);
    w0 = __builtin_amdgcn_cvt_scalef32_pk_fp4_f32(w0, v[j][0][2] * sc, v[j][0][3] * sc, 1.0f, 1);
    w0 = __builtin_amdgcn_cvt_scalef32_pk_fp4_f32(w0, v[j][1][0] * sc, v[j][1][1] * sc, 1.0f, 2);
    w0 = __builtin_amdgcn_cvt_scalef32_pk_fp4_f32(w0, v[j][1][2] * sc, v[j][1][3] * sc, 1.0f, 3);
    w1 = __builtin_amdgcn_cvt_scalef32_pk_fp4_f32(w1, v[j][2][0] * sc, v[j][2][1] * sc, 1.0f, 0);
    w1 = __builtin_amdgcn_cvt_scalef32_pk_fp4_f32(w1, v[j][2][2] * sc, v[j][2][3] * sc, 1.0f, 1);
    w1 = __builtin_amdgcn_cvt_scalef32_pk_fp4_f32(w1, v[j][3][0] * sc, v[j][3][1] * sc, 1.0f, 2);
    w1 = __builtin_amdgcn_cvt_scalef32_pk_fp4_f32(w1, v[j][3][2] * sc, v[j][3][3] * sc, 1.0f, 3);
    *(u32x2*)(base + (size_t)(row0 + j) * 512 + lane * 8) = (u32x2){w0, w1};
    if (lane == 0) ((float*)(base + 16 * MiB))[row0 + j] = m * (1.f / 6.f);
  }
}
DI int t5_bucket(int n) {
  if (n < 16) return n;
  int b = 16 + (int)(logf((float)n * (1.f / 16.f)) / logf(8.f) * 16.f);
  return b > 31 ? 31 : b;
}
constexpr int T0_WIN = 16 * 46, T0_WOUT = 16 * 16, T0_W1 = 32 * 4, T0_W2 = 4 * 2;
constexpr int T0_A = 0, T0_B = T0_A + T0_WIN, T0_C = T0_B + T0_WOUT, T0_D = T0_C + T0_W1, T0_E = T0_D + T0_W1, T0_F = T0_E + T0_W2, T0_G = T0_F + T0_W2;
constexpr int T0_CVQ = 1024, T0_CVS = 128, T0_CVU = 1024;
constexpr int T0_H = T0_G + T0_CVQ, T0_I = T0_H + T0_CVS, T0_K = T0_I;
constexpr int T0_MISC = 33;
constexpr int T0_L = T0_K + T0_MISC;
constexpr int T0_NORM = NTOK / 16;
constexpr int T0_END = T0_L + T0_NORM;

DI void phase0(const Params& p, lptr L, int wv, int bid, int nb) {
  char* ws = p.ws;
  for (int t0_ = bid; t0_ < T0_END; t0_ += nb) {
    const int t = t0_ < T0_MISC ? T0_K + t0_ : (t0_ < T0_L ? t0_ - T0_MISC : t0_);
    const int tid = task_tid(wv);
    if (t < T0_B) { int q = t - T0_A; transpose_tile(p.w_in, 2840, (bf16_t*)(ws + OFF_WINT), 1024, q / 46, q % 46, L, tid); }
    else if (t < T0_C) { int q = t - T0_B; transpose_tile(p.w_out, 1024, (bf16_t*)(ws + OFF_WOUTT), 1024, q / 16, q % 16, L, tid); }
    else if (t < T0_D) { int q = t - T0_C; transpose_tile(p.w1k, 256, (bf16_t*)(ws + OFF_W1KT), 2048, q / 4, q % 4, L, tid); }
    else if (t < T0_E) { int q = t - T0_D; transpose_tile(p.w1v, 256, (bf16_t*)(ws + OFF_W1VT), 2048, q / 4, q % 4, L, tid); }
    else if (t < T0_F) { int q = t - T0_E; transpose_tile(p.w2k, 64, (bf16_t*)(ws + OFF_W2KT), 256, q / 2, q % 2, L, tid); }
    else if (t < T0_G) { int q = t - T0_F; transpose_tile(p.w2v, 64, (bf16_t*)(ws + OFF_W2VT), 256, q / 2, q % 2, L, tid); }
    else if (t < T0_H) convert_chunk(p.wq, (bf16_t*)(ws + OFF_WQB), t - T0_G, tid);
    else if (t < T0_I) convert_chunk(p.subk, (bf16_t*)(ws + OFF_SUBK), t - T0_H, tid);
    else if (t < T0_L) {
      int q = t - T0_K;
      float* misc = (float*)(ws + OFF_MISC);
      if (q < 32) {
        const int which = q >> 4, ch = q & 15;
        const float* pos = (which ? p.pos_v : p.pos_k) + ch * 128; const float* w1 = (which ? p.w1v : p.w1k) + (size_t)ch * 128 * 256;
        float a0 = 0.f, a1 = 0.f, a2 = 0.f, a3 = 0.f;
#pragma unroll 8
        for (int i = 0; i < 128; i += 4) {
          a0 += pos[i] * w1[(size_t)i * 256 + tid]; a1 += pos[i + 1] * w1[(size_t)(i + 1) * 256 + tid];
          a2 += pos[i + 2] * w1[(size_t)(i + 2) * 256 + tid]; a3 += pos[i + 3] * w1[(size_t)(i + 3) * 256 + tid];
        }
        misc[8192 + (which * 16 + ch) * 256 + tid] = (a0 + a1) + (a2 + a3);
      } else {
        float* btab = misc + 1024;
        for (int e = tid; e < 12 * 256; e += 256) { int h = e >> 8, rel = e & 255; btab[e] = p.rel_bias[t5_bucket(rel) * 12 + h] * LOG2E; }
        if (tid < 64) {
          float a = wave_sum(p.lq1[tid] * p.lk1[tid]), b = wave_sum(p.lq2[tid] * p.lk2[tid]);
          if (tid == 0) misc[512] = __expf(a) - __expf(b) + 0.2f;
        }
      }
    } else {
      const int row = (t - T0_L) * 16 + wv * 4;
      rmsnorm_rows4_bf16(p.x + (size_t)row * DM, p.g_mix, (bf16_t*)(ws + OFF_XN) + (size_t)row * DM, tid & 63);
    }
  }
}

DI void glds16(const bf16_t* g, lptr l) {
  __builtin_amdgcn_global_load_lds((const unsigned*)g, (__attribute__((address_space(3))) unsigned*)l, 16, 0, 0);
}
typedef decltype(__builtin_amdgcn_make_buffer_rsrc((void*)nullptr, 0, 0, 0)) rsrc_t;
DI rsrc_t make_rsrc(const void* p) { return __builtin_amdgcn_make_buffer_rsrc((void*)p, 0, 0x7fffffff, 0x00020000); }
DI void bdma16(rsrc_t r, unsigned voff, unsigned soff, lptr lbase) {
  __builtin_amdgcn_raw_ptr_buffer_load_lds(r, (__attribute__((address_space(3))) void*)lbase, 16, voff, soff, 0, 0);
}
template <class Epi>
DI void gemm_tile(const bf16_t* __restrict__ A, int lda, const bf16_t* __restrict__ Bt, int ldb, int K, int m0, int n0, lptr L, int wv, const Epi& epi) {
  const int tid = task_tid(wv);
  const int lane = tid & 63, w = tid >> 6, r32 = lane & 31, hi = lane >> 5;
  const int wm = w >> 1, wn = w & 1;
  const int srow = tid >> 3, sch = (tid & 7) ^ ((tid >> 4) & 7);
  const rsrc_t rA = make_rsrc(A), rB = make_rsrc(Bt);
  const unsigned voA = (unsigned)(srow * lda + sch * 8) * 2u, voB = (unsigned)(srow * ldb + sch * 8) * 2u;
  const unsigned soA = (unsigned)m0 * (unsigned)lda * 2u, soB = (unsigned)n0 * (unsigned)ldb * 2u;
  lptr Lw = L + wv * 1024;
  f32x16 acc[2][2];
#pragma unroll
  for (int i = 0; i < 2; ++i)
#pragma unroll
    for (int j = 0; j < 2; ++j)
#pragma unroll
      for (int r = 0; r < 16; ++r) acc[i][j][r] = 0.f;
#define G_STAGE(buf, k0) do { lptr d_ = Lw + (buf) * 32768; _Pragma("unroll") for (int i_ = 0; i_ < 4; ++i_) { \
      bdma16(rA, voA, soA + (unsigned)(32 * i_ * lda + (k0)) * 2u, d_ + i_ * 4096); bdma16(rB, voB, soB + (unsigned)(32 * i_ * ldb + (k0)) * 2u, d_ + 16384 + i_ * 4096); } } while (0)
  const int sw = (r32 >> 1) & 7;
  int co[4];
#pragma unroll
  for (int ks = 0; ks < 4; ++ks) co[ks] = (((2 * ks + hi) ^ sw) * 16);
  lcptr abase = L + (wm * 64 + r32) * 128, bbase = L + 16384 + (wn * 64 + r32) * 128;
  const int nk = K >> 6;
  G_STAGE(0, 0);
  asm volatile("s_waitcnt vmcnt(0)" ::: "memory");
  __syncthreads();
#define G_BODY(DMA) do { \
    lcptr a = abase + (kt & 1) * 32768, b = bbase + (kt & 1) * 32768; \
    lptr dn = Lw + ((kt + 1) & 1) * 32768; const int k1 = (kt + 1) * 64; \
    _Pragma("unroll") for (int ks = 0; ks < 4; ++ks) { \
      bf16x8 a0 = lds_r128(a + co[ks]), a1 = lds_r128(a + 32 * 128 + co[ks]); \
      bf16x8 b0 = lds_r128(b + co[ks]), b1 = lds_r128(b + 32 * 128 + co[ks]); \
      acc[0][0] = MFMA32(a0, b0, acc[0][0]); \
      if (DMA && ks < 2) bdma16(rA, voA, soA + (unsigned)(64 * ks * lda + k1) * 2u, dn + ks * 8192); \
      acc[0][1] = MFMA32(a0, b1, acc[0][1]); \
      if (DMA && ks < 2) bdma16(rB, voB, soB + (unsigned)(64 * ks * ldb + k1) * 2u, dn + 16384 + ks * 8192); \
      acc[1][0] = MFMA32(a1, b0, acc[1][0]); \
      if (DMA && ks < 2) bdma16(rA, voA, soA + (unsigned)((64 * ks + 32) * lda + k1) * 2u, dn + ks * 8192 + 4096); \
      acc[1][1] = MFMA32(a1, b1, acc[1][1]); \
      if (DMA && ks < 2) bdma16(rB, voB, soB + (unsigned)((64 * ks + 32) * ldb + k1) * 2u, dn + 16384 + ks * 8192 + 4096); \
    } \
    asm volatile("s_waitcnt vmcnt(0)" ::: "memory"); \
    __syncthreads(); } while (0)
  int kt = 0;
  for (; kt + 1 < nk; ++kt) G_BODY(1);
  G_BODY(0);
#undef G_BODY
#undef G_STAGE
  {
    lptr st = L + ((wm * 64 + 4 * hi) * 132 + wn * 64 + r32) * 4;
#pragma unroll
    for (int i = 0; i < 2; ++i)
#pragma unroll
      for (int j = 0; j < 2; ++j)
#pragma unroll
        for (int r = 0; r < 16; ++r) lds_wf(st + ((i * 32 + crow0(r)) * 132 + j * 32) * 4, acc[i][j][r]);
  }
  __syncthreads();
  {
    const int c4 = tid & 31, rr = tid >> 5;
#pragma unroll 4
    for (int it = 0; it < 16; ++it) {
      const int row = it * 8 + rr;
      const f32x4 v = *(const __attribute__((address_space(3))) f32x4*)(L + (row * 132 + c4 * 4) * 4);
      epi(m0 + row, n0 + c4 * 4, v);
    }
  }
  __syncthreads();
}

template <class F>
DI void for_each_tile_patched(int bid, int nb, int MT, int NT, const F& f) {
  if (nb == 512) {
    const int x = bid & 7, i = bid >> 3, pcols = (NT + 7) >> 3, npatch = (MT >> 3) * pcols;
    for (int pidx = x; pidx < npatch; pidx += 8) {
      const int mt = (pidx / pcols) * 8 + (i >> 3), nt = (pidx % pcols) * 8 + (i & 7);
      if (nt < NT) f(mt, nt);
    }
  } else {
    for (int t = bid; t < MT * NT; t += nb) f(t / NT, t % NT);
  }
}
struct EpiInProj {
  bf16_t* proj; float* gates;
  DI void operator()(int row, int col, const f32x4& v) const {
    if (col < 2816) {
      const int slot = col >> 6, d = col & 63;
      const float sc = (slot < 8 || (slot >= 24 && slot < 32)) ? QSCALE : 1.f;
      *(u32x2*)(proj + (size_t)slot * SLOT + (size_t)row * 64 + d) = (u32x2){cvtpk(v[0] * sc, v[1] * sc), cvtpk(v[2] * sc, v[3] * sc)};
    } else if (col < 2840) {
      *(f32x4*)(gates + (size_t)row * 24 + (col - 2816)) = v;
    }
  }
};
struct EpiBf16 {
  bf16_t* c; int ldc; int ncols;
  DI void operator()(int row, int col, const f32x4& v) const {
    if (col < ncols) *(u32x2*)(c + (size_t)row * ldc + col) = (u32x2){cvtpk(v[0], v[1]), cvtpk(v[2], v[3])};
  }
};
struct EpiGeluBias {
  bf16_t* c; int ldc; const float* cb;
  DI void operator()(int row, int col, const f32x4& v) const {
    f32x4 b = {0.f, 0.f, 0.f, 0.f};
#pragma unroll
    for (int i = 0; i < 16; ++i) { const f32x4 t = *(const f32x4*)(cb + i * 256 + col); b += t; }
    *(u32x2*)(c + (size_t)row * ldc + col) = (u32x2){cvtpk(gelu_tanh(v[0] + b[0]), gelu_tanh(v[1] + b[1])), cvtpk(gelu_tanh(v[2] + b[2]), gelu_tanh(v[3] + b[3]))};
  }
};
struct EpiResid {
  const float* x; bf16_t* o;
  DI void operator()(int row, int col, const f32x4& v) const {
    const size_t i = (size_t)row * DM + col;
    const f32x4 xv = *(const f32x4*)(x + i);
    *(u32x2*)(o + i) = (u32x2){cvtpk(xv[0] + v[0], xv[1] + v[1]), cvtpk(xv[2] + v[2], xv[3] + v[3])};
  }
};

constexpr int T1_IN = 256 * 23, T1_END = T1_IN + 128;
DI void phase1(const Params& p, lptr L, int wv, int bid, int nb) {
  char* ws = p.ws;
  for (int q = bid; q < 128; q += nb) {
    const int hp = q >> 3, dt = q & 7;
    EpiBf16 e{(bf16_t*)(ws + OFF_WPT) + (size_t)hp * 128 * DM, DM, DM};
    gemm_tile((const bf16_t*)(ws + OFF_SUBK) + (size_t)hp * 128 * 128, 128, (const bf16_t*)(ws + OFF_WQB) + hp * 128, 2048, 128, 0, dt * 128, L, wv, e);
  }
  for_each_tile_patched(bid, nb, 256, 23, [&](int mt, int nt) {
    EpiInProj e{(bf16_t*)(ws + OFF_PROJ), (float*)(ws + OFF_GATES)};
    gemm_tile((const bf16_t*)(ws + OFF_XN), DM, (const bf16_t*)(ws + OFF_WINT), DM, DM, mt * 128, nt * 128, L, wv, e);
  });
  for (int q = bid; q < 2 * T0_CVU; q += nb) {
    const int lane = task_tid(wv) & 63;
    if (q < T0_CVU) quant_rows4_fp4(p.pu, ws + OFF_U, q * 16 + wv * 4, lane);
    else quant_rows4_fp4(p.pv, ws + OFF_V, (q - T0_CVU) * 16 + wv * 4, lane);
  }
}

template <int NDB, class Adj>
DI void flash_tile(lcptr Kt, lcptr Vt, const bf16x8 (&q)[4], f32x16 (&o)[NDB], float& mref, float& lsum, lptr wsf, int lane, const Adj& adj, bool first) {
  const int r32 = lane & 31, hi = lane >> 5;
  const float c = adj.base() - mref;
  f32x16 p0, p1;
#pragma unroll
  for (int r = 0; r < 16; ++r) { p0[r] = c; p1[r] = c; }
  lcptr kp = Kt + r32 * 128;
  const int ksw = (r32 >> 1) & 7;
#pragma unroll
  for (int s = 0; s < 4; ++s) {
    const int kc = ((2 * s + hi) ^ ksw) * 16;
    bf16x8 k0 = lds_r128(kp + kc), k1 = lds_r128(kp + 32 * 128 + kc);
    p0 = MFMA32(k0, q[s], p0); p1 = MFMA32(k1, q[s], p1);
  }
  adj(p0, 0); adj(p1, 32);
  float rm = p0[0];
#pragma unroll
  for (int r = 1; r < 16; ++r) rm = fmaxf(rm, p0[r]);
#pragma unroll
  for (int r = 0; r < 16; ++r) rm = fmaxf(rm, p1[r]);
  rm = xor32_max(rm);
  if (__any(first || rm > RTHR)) {
    const float d = first ? fmaxf(rm, -1000.f) : fmaxf(rm, 0.f);
    const float f = first ? 1.f : __builtin_amdgcn_exp2f(-d);
    mref += d; lsum *= f;
    if (hi == 0) lds_wf(wsf + r32 * 4, f);
#pragma unroll
    for (int r = 0; r < 16; ++r) {
      const float fr = lds_rf(wsf + hi * 16 + crow0(r) * 4);
#pragma unroll
      for (int db = 0; db < NDB; ++db) o[db][r] *= fr;
    }
#pragma unroll
    for (int r = 0; r < 16; ++r) { p0[r] -= d; p1[r] -= d; }
  }
  float s = 0.f;
#pragma unroll
  for (int r = 0; r < 16; ++r) { p0[r] = __builtin_amdgcn_exp2f(p0[r]); p1[r] = __builtin_amdgcn_exp2f(p1[r]); s += p0[r] + p1[r]; }
  lsum += s;
  bf16x8 pw[4];
  pw[0] = __builtin_bit_cast(bf16x8, (u32x4){cvtpk(p0[0], p0[1]), cvtpk(p0[2], p0[3]), cvtpk(p0[4], p0[5]), cvtpk(p0[6], p0[7])});
  pw[1] = __builtin_bit_cast(bf16x8, (u32x4){cvtpk(p0[8], p0[9]), cvtpk(p0[10], p0[11]), cvtpk(p0[12], p0[13]), cvtpk(p0[14], p0[15])});
  pw[2] = __builtin_bit_cast(bf16x8, (u32x4){cvtpk(p1[0], p1[1]), cvtpk(p1[2], p1[3]), cvtpk(p1[4], p1[5]), cvtpk(p1[6], p1[7])});
  pw[3] = __builtin_bit_cast(bf16x8, (u32x4){cvtpk(p1[8], p1[9]), cvtpk(p1[10], p1[11]), cvtpk(p1[12], p1[13]), cvtpk(p1[14], p1[15])});
  lcptr vp = Vt + (4 * hi + ((lane & 15) >> 2)) * 64 + ((lane >> 4) & 1) * 32 + (lane & 3) * 8;
#pragma unroll
  for (int db = 0; db < NDB; ++db)
#pragma unroll
    for (int s4 = 0; s4 < 4; ++s4) {
      s16x4 lo = vtr(vp + db * 4096 + s4 * 1024), hh = vtr(vp + db * 4096 + s4 * 1024 + 512);
      bf16x8 vf = (bf16x8){lo[0], lo[1], lo[2], lo[3], hh[0], hh[1], hh[2], hh[3]};
      o[db] = MFMA32(pw[s4], vf, o[db]);
    }
}
DI void load_q(bf16x8 (&q)[4], const bf16_t* qrow, int hi) {
#pragma unroll
  for (int s = 0; s < 4; ++s) q[s] = *(const bf16x8*)(qrow + s * 16 + hi * 8);
}

struct AdjDiff {
  lcptr ab; bool far; float bfar;
  DI float base() const { return far ? bfar : 0.f; }
  DI void operator()(f32x16& p, int koff) const {
    if (!far) {
#pragma unroll
      for (int r = 0; r < 16; ++r) p[r] += lds_rf(ab + (koff + crow0(r)) * 4);
    }
  }
};
constexpr int DIFF_M0 = 224, DIFF_TM = 288;
constexpr int DIFF_BUF = 32768;
constexpr int DIFF_WSF = 2 * DIFF_BUF;
constexpr int DIFF_BTAB = DIFF_WSF + 1024;
DI void diff_task(const Params& p, lptr L, int wv, int b, int h, int qt) {
  char* ws = p.ws; asm volatile("" : "+s"(ws));
  const int tid = task_tid(wv);
  const int lane = tid & 63, w = tid >> 6, r32 = lane & 31, hi = lane >> 5;
  const int comp = w & 1, half = w >> 1;
  const bf16_t* proj = (const bf16_t*)(ws + OFF_PROJ);
  const float* misc = (const float*)(ws + OFF_MISC);
  const int t0 = qt * 64;
  const size_t tokbase = (size_t)b * SEQ;
  for (int m = tid; m < DIFF_TM; m += 256) { const int rel = DIFF_M0 - m; lds_wf(L + DIFF_BTAB + m * 4, rel < 0 ? NEGBIG : misc[1024 + h * 256 + (rel > 255 ? 255 : rel)]); }
  const float bfar = misc[1024 + h * 256 + 255];
  const int qpos = t0 + half * 32 + r32;
  bf16x8 q[4];
  load_q(q, proj + (size_t)(2 * h + comp) * SLOT + (tokbase + qpos) * 64, hi);
  f32x16 o[4];
#pragma unroll
  for (int db = 0; db < 4; ++db)
#pragma unroll
    for (int r = 0; r < 16; ++r) o[db][r] = 0.f;
  float mref = 0.f, lsum = 0.f;
  lptr wsf = L + DIFF_WSF + w * 256;
  const int NT = qt + 1;
  const bf16_t* k0g = proj + (size_t)(8 + 2 * h) * SLOT + tokbase * 64;
  const bf16_t* k1g = proj + (size_t)(9 + 2 * h) * SLOT + tokbase * 64;
  const bf16_t* v0g = proj + (size_t)(16 + 2 * h) * SLOT + tokbase * 64;
  const bf16_t* v1g = proj + (size_t)(17 + 2 * h) * SLOT + tokbase * 64;
  const int krow = tid >> 3, kch = (tid & 7) ^ ((tid >> 4) & 7);
  const int vkey = tid >> 2, vc = tid & 3;
#define D_STAGE(buf, j) do { const size_t kb_ = (size_t)(j) * 64; lptr b_ = L + (buf) * DIFF_BUF + tid * 16; \
      glds16(k0g + (kb_ + krow) * 64 + kch * 8, b_); glds16(k0g + (kb_ + krow + 32) * 64 + kch * 8, b_ + 4096); \
      glds16(k1g + (kb_ + krow) * 64 + kch * 8, b_ + 8192); glds16(k1g + (kb_ + krow + 32) * 64 + kch * 8, b_ + 12288); \
      glds16(v0g + (kb_ + vkey) * 64 + vc * 8, b_ + 16384); glds16(v0g + (kb_ + vkey) * 64 + 32 + vc * 8, b_ + 20480); \
      glds16(v1g + (kb_ + vkey) * 64 + vc * 8, b_ + 24576); glds16(v1g + (kb_ + vkey) * 64 + 32 + vc * 8, b_ + 28672); } while (0)
  D_STAGE(0, 0);
  asm volatile("s_waitcnt vmcnt(0)" ::: "memory");
  __syncthreads();
  for (int j = 0; j < NT; ++j) {
    if (j + 1 < NT) D_STAGE((j + 1) & 1, j + 1);
    lcptr bufp = L + (j & 1) * DIFF_BUF;
    AdjDiff adj{L + DIFF_BTAB + (DIFF_M0 - (qpos - j * 64 - 4 * hi)) * 4, (t0 + half * 32) - (j * 64 + 63) >= 128, bfar};
    flash_tile<4>(bufp + comp * 8192, bufp + 16384, q, o, mref, lsum, wsf, lane, adj, j == 0);
    asm volatile("s_waitcnt vmcnt(0)" ::: "memory");
    __syncthreads();
  }
#undef D_STAGE
  lsum = xor32_sum(lsum);
  if (hi == 0) lds_wf(wsf + r32 * 4, 1.f / lsum);
  float il[16];
#pragma unroll
  for (int r = 0; r < 16; ++r) il[r] = lds_rf(wsf + hi * 16 + crow0(r) * 4);
  const float lam = misc[512];
  lptr X = L;
  lptr Xb = X + ((half * 32 + 4 * hi) * 132 + r32) * 4;
  if (comp == 1) {
#pragma unroll
    for (int db = 0; db < 4; ++db)
#pragma unroll
      for (int r = 0; r < 16; ++r) lds_wf(Xb + (crow0(r) * 132 + db * 32) * 4, o[db][r] * il[r] * lam);
  }
  __syncthreads();
  if (comp == 0) {
#pragma unroll
    for (int db = 0; db < 4; ++db)
#pragma unroll
      for (int r = 0; r < 16; ++r) {
        lptr a = Xb + (crow0(r) * 132 + db * 32) * 4;
        lds_wf(a, o[db][r] * il[r] - lds_rf(a));
      }
  }
  __syncthreads();
  {
    const int tok = tid >> 2, part = tid & 3;
    float v[32]; float ss = 0.f;
#pragma unroll
    for (int i = 0; i < 32; ++i) { v[i] = lds_rf(X + (tok * 132 + part * 32 + i) * 4); ss += v[i] * v[i]; }
    ss += __shfl_xor(ss, 1); ss += __shfl_xor(ss, 2);
    const float rs = rsqrtf(ss * (1.f / 128.f) + 1e-6f) * 0.8f;
    const float* g = p.subln + part * 32;
    bf16_t* op = (bf16_t*)(ws + OFF_ATT) + (tokbase + t0 + tok) * DM + h * 128 + part * 32;
#pragma unroll
    for (int i = 0; i < 4; ++i) {
      u32x4 wv;
#pragma unroll
      for (int k = 0; k < 4; ++k) wv[k] = cvtpk(v[i * 8 + 2 * k] * rs * g[i * 8 + 2 * k], v[i * 8 + 2 * k + 1] * rs * g[i * 8 + 2 * k + 1]);
      *(u32x4*)(op + i * 8) = wv;
    }
  }
  __syncthreads();
}
constexpr int T2_CMP = 2 * 32 * 2, T2_DIFF = 2048, T2_END = T2_CMP + T2_DIFF;
DI void phase2(const Params& p, lptr L, int wv, int bid, int nb) {
  char* ws = p.ws;
  for (int t = bid; t < T2_END; t += nb) {
    if (t < T2_CMP) {
      const int which = t >> 6, mt = (t >> 1) & 31, nt = t & 1;
      EpiGeluBias e{(bf16_t*)(ws + OFF_HID) + (size_t)which * 4096 * 256, 256, (const float*)(ws + OFF_MISC) + 8192 + which * 16 * 256};
      gemm_tile((const bf16_t*)(ws + OFF_PROJ) + (size_t)(32 + 2 * which) * SLOT, 1024, (const bf16_t*)(ws + (which ? OFF_W1VT : OFF_W1KT)), 2048, 2048, mt * 128, nt * 128, L, wv, e);
    } else {
      const int q = t - T2_CMP, qt = 31 - (q >> 6), bh = q & 63;
      diff_task(p, L, wv, bh >> 2, bh & 3, qt);
    }
  }
}
constexpr int T2B_END = 2 * 32;
DI void phase2b(const Params& p, lptr L, int wv, int bid, int nb) {
  char* ws = p.ws;
  for (int t = bid; t < T2B_END; t += nb) {
    const int which = t >> 5, mt = t & 31;
    EpiBf16 e{(bf16_t*)(ws + OFF_KCMP) + (size_t)which * 4096 * 64, 64, 64};
    gemm_tile((const bf16_t*)(ws + OFF_HID) + (size_t)which * 4096 * 256, 256, (const bf16_t*)(ws + (which ? OFF_W2VT : OFF_W2KT)), 256, 256, mt * 128, 0, L, wv, e);
  }
}

constexpr int NSA_TILE = 16384;
constexpr int NSA_PSUM = 34816;
constexpr int NSA_SC = NSA_PSUM + 16512;
constexpr int NSA_SELM = NSA_SC + 4608;
constexpr int NSA_WSF = NSA_SELM + 128;
constexpr int NSA_BTAB = NSA_WSF + 4096;
struct AdjSel {
  lcptr ab; bool far; bool on; float bfar;
  DI float base() const { return on ? (far ? bfar : 0.f) : NEGBIG; }
  DI void operator()(f32x16& p, int koff) const {
    if (!far) {
#pragma unroll
      for (int r = 0; r < 16; ++r) p[r] += lds_rf(ab + (koff + crow0(r)) * 4);
    }
  }
};
struct AdjWin {
  lcptr ab; bool mid; float bfar;
  DI float base() const { return mid ? bfar : 0.f; }
  DI void operator()(f32x16& p, int koff) const {
    if (!mid) {
#pragma unroll
      for (int r = 0; r < 16; ++r) p[r] += lds_rf(ab + (koff + crow0(r)) * 4);
    }
  }
};
constexpr int NSA_M0 = 608, NSA_TM = 672;
static_assert(NSA_BTAB + 4 * NSA_TM * 4 <= LDS_BYTES - 16, "nsa lds");
DI void nsa_task(const Params& p, lptr L, int wv, int b, int hkv, int qt, int task) {
  char* ws = p.ws; asm volatile("" : "+s"(ws));
  const int tid = task_tid(wv);
  const int lane = tid & 63, w = tid >> 6, r32 = lane & 31, hi = lane >> 5;
  const bf16_t* proj = (const bf16_t*)(ws + OFF_PROJ);
  const float* misc = (const float*)(ws + OFF_MISC);
  const int t0 = qt * 32, hq = hkv * 4 + w;
  const size_t tokbase = (size_t)b * SEQ;
  const int qpos = t0 + r32;
  const int cur = t0 >> 6;
  lptr wsf = L + NSA_WSF + w * 1024;
#pragma unroll
  for (int e = tid; e < 4 * NSA_TM; e += 256) {
    const int i = e / NSA_TM, rel = NSA_M0 - (e - i * NSA_TM);
    lds_wf(L + NSA_BTAB + e * 4, (rel < 0 || rel > 511) ? NEGBIG : misc[1024 + (4 + hkv * 4 + i) * 256 + (rel > 255 ? 255 : rel)]);
  }
  lcptr btab = L + NSA_BTAB + w * (NSA_TM * 4);
  const float bfar = misc[1024 + (4 + hq) * 256 + 255];
  bf16x8 q[4];
  load_q(q, proj + (size_t)(24 + hq) * SLOT + (tokbase + qpos) * 64, hi);
  const float* gl = (const float*)(ws + OFF_GATES) + (tokbase + qpos) * 24 + hq * 3;
  lptr wscr = wsf + 384;
  f32x16 res[2];

  {
    const bf16_t* kc = (const bf16_t*)(ws + OFF_KCMP) + (size_t)((hkv * 16 + b) * 128) * 64;
    const bf16_t* vc = kc + (size_t)4096 * 64;
    const int key0 = tid >> 3, ch = tid & 7;
    const bf16_t* kcp = kc + key0 * 64 + ch * 8; const bf16_t* vcp = vc + key0 * 64 + ch * 8;
    lptr kd = L + key0 * 128 + ((ch ^ ((key0 >> 1) & 7)) * 16), vd = L + 18432 + (ch >> 2) * 8192 + key0 * 64 + (ch & 3) * 16;
#pragma unroll
    for (int i = 0; i < 4; ++i) {
      u32x4 kk = *(const u32x4*)(kcp + i * 32 * 64), vv = *(const u32x4*)(vcp + i * 32 * 64);
      lds_w128(kd + i * 32 * 128, kk);
      lds_w128(vd + i * 32 * 64, vv);
    }
  }
  __syncthreads();
  {
    f32x16 ocmp[2];
    f32x16 pc[4];
#pragma unroll
    for (int kb = 0; kb < 4; ++kb) {
#pragma unroll
      for (int r = 0; r < 16; ++r) pc[kb][r] = 0.f;
      lcptr kp = L + (kb * 32 + r32) * 128;
#pragma unroll
      for (int s = 0; s < 4; ++s) pc[kb] = MFMA32(lds_r128(kp + (((2 * s + hi) ^ ((r32 >> 1) & 7)) * 16)), q[s], pc[kb]);
    }
    const int nvalid = qpos >= 31 ? ((qpos - 31) >> 4) + 1 : 0;
    const int nvh = nvalid - 4 * hi;
    float rm = NEGBIG;
#pragma unroll
    for (int kb = 0; kb < 4; ++kb)
#pragma unroll
      for (int r = 0; r < 16; ++r) { const bool ok = (kb * 32 + crow0(r)) < nvh; pc[kb][r] = ok ? pc[kb][r] : NEGBIG; rm = fmaxf(rm, pc[kb][r]); }
    rm = xor32_max(rm);
    float s = 0.f;
#pragma unroll
    for (int kb = 0; kb < 4; ++kb)
#pragma unroll
      for (int r = 0; r < 16; ++r) { pc[kb][r] = __builtin_amdgcn_exp2f(pc[kb][r] - rm); s += pc[kb][r]; }
    s = xor32_sum(s);
    const float inv = nvalid > 0 ? 1.f / s : 0.f;
#pragma unroll
    for (int kb = 0; kb < 4; ++kb)
#pragma unroll
      for (int r = 0; r < 16; ++r) pc[kb][r] *= inv;
#pragma unroll
    for (int db = 0; db < 2; ++db)
#pragma unroll
      for (int r = 0; r < 16; ++r) ocmp[db][r] = 0.f;
    lcptr vp = L + 18432 + (4 * hi + ((lane & 15) >> 2)) * 64 + ((lane >> 4) & 1) * 32 + (lane & 3) * 8;
#pragma unroll
    for (int s8 = 0; s8 < 8; ++s8) {
      const int kb = s8 >> 1, r0 = (s8 & 1) * 8;
      bf16x8 pw = __builtin_bit_cast(bf16x8, (u32x4){cvtpk(pc[kb][r0], pc[kb][r0 + 1]), cvtpk(pc[kb][r0 + 2], pc[kb][r0 + 3]), cvtpk(pc[kb][r0 + 4], pc[kb][r0 + 5]), cvtpk(pc[kb][r0 + 6], pc[kb][r0 + 7])});
#pragma unroll
      for (int db = 0; db < 2; ++db) {
        s16x4 lo = vtr(vp + db * 8192 + s8 * 1024), hh = vtr(vp + db * 8192 + s8 * 1024 + 512);
        bf16x8 vf = (bf16x8){lo[0], lo[1], lo[2], lo[3], hh[0], hh[1], hh[2], hh[3]};
        ocmp[db] = MFMA32(pw, vf, ocmp[db]);
      }
    }
    if (hi == 0) lds_wf(wscr + 128 + r32 * 4, 1.f / (1.f + __expf(-gl[0])));
#pragma unroll
    for (int r = 0; r < 16; ++r) {
      const float g0 = lds_rf(wscr + hi * 16 + 128 + crow0(r) * 4);
#pragma unroll
      for (int db = 0; db < 2; ++db) { res[db][r] = g0 * ocmp[db][r]; asm volatile("" : "+v"(res[db][r])); }
    }
#pragma nounroll
    for (int g = 0; g < 4; ++g) {
      if (w == g) {
#pragma unroll
        for (int kb = 0; kb < 4; ++kb)
#pragma unroll
          for (int r = 0; r < 16; ++r) {
            lptr a = L + NSA_PSUM + (r32 * 129 + 4 * hi) * 4 + (kb * 32 + crow0(r)) * 4;
            lds_wf(a, g == 0 ? pc[kb][r] : lds_rf(a) + pc[kb][r]);
          }
      }
      __syncthreads();
    }
  }
  {
    const int tok = tid >> 3, sub = tid & 7;
    lcptr ps = L + NSA_PSUM + tok * 129 * 4;
#pragma unroll
    for (int jj = 0; jj < 4; ++jj) {
      const int j = sub * 4 + jj;
      float imp = 2.f * (lds_rf(ps + (4 * j) * 4) + lds_rf(ps + (4 * j + 1) * 4) + lds_rf(ps + (4 * j + 2) * 4)) + lds_rf(ps + (4 * j + 3) * 4);
      if (j > 0) imp += lds_rf(ps + (4 * j - 1) * 4);
      const bool forced = (j == 0) || (j == cur) || (j == cur - 1);
      const float sc = (j <= cur) ? imp + (forced ? 1000.f : 0.f) : NEGBIG;
      lds_wf(L + NSA_SC + (tok * 36 + j) * 4, sc);
    }
  }
  __syncthreads();
  {
    const int tok = tid >> 3, sub = tid & 7;
    float sv[32];
#pragma unroll
    for (int c = 0; c < 8; ++c) {
      const f32x4 t4 = *(const __attribute__((address_space(3))) f32x4*)(L + NSA_SC + (tok * 36 + c * 4) * 4);
      sv[4 * c] = t4[0]; sv[4 * c + 1] = t4[1]; sv[4 * c + 2] = t4[2]; sv[4 * c + 3] = t4[3];
    }
    unsigned bits = 0;
#pragma unroll
    for (int jj = 0; jj < 4; ++jj) {
      float mine = sv[jj];
#pragma unroll
      for (int c = 1; c < 8; ++c) mine = (sub == c) ? sv[4 * c + jj] : mine;
      const int j = sub * 4 + jj;
      int rank = 0;
#pragma unroll
      for (int k = 0; k < 32; ++k) rank += (sv[k] > mine || (sv[k] == mine && k < j)) ? 1 : 0;
      if (rank < 8 && mine > 0.5f * NEGBIG) bits |= 1u << j;
    }
    bits |= (unsigned)__builtin_amdgcn_mov_dpp((int)bits, 0xB1, 0xF, 0xF, true);
    bits |= (unsigned)__builtin_amdgcn_mov_dpp((int)bits, 0x4E, 0xF, 0xF, true);
    bits |= (unsigned)__builtin_amdgcn_ds_swizzle((int)bits, 0x1F | (4 << 10));
    if (sub == 0) lds_wu(L + NSA_SELM + tok * 4, bits);
  }
  __syncthreads();
  const unsigned selm = lds_ru(L + NSA_SELM + r32 * 4);
  unsigned umask = 0;
  for (int i = 0; i < 32; ++i) umask |= lds_ru(L + NSA_SELM + i * 4);
  __syncthreads();

  const int krow = tid >> 3, kch = (tid & 7) ^ ((tid >> 4) & 7);
  const int vkey = tid >> 2, vc = tid & 3;
#define N_STAGE(kg, vg, buf, j) do { const size_t kb_ = (size_t)(j) * 64; lptr b_ = L + (buf) * NSA_TILE + tid * 16; \
      glds16((kg) + (kb_ + krow) * 64 + kch * 8, b_); glds16((kg) + (kb_ + krow + 32) * 64 + kch * 8, b_ + 4096); \
      glds16((vg) + (kb_ + vkey) * 64 + vc * 8, b_ + 8192); glds16((vg) + (kb_ + vkey) * 64 + 32 + vc * 8, b_ + 12288); } while (0)
#define N_WAIT(more) do { if (more) asm volatile("s_waitcnt vmcnt(4)" ::: "memory"); else asm volatile("s_waitcnt vmcnt(0)" ::: "memory"); __syncthreads(); } while (0)
  f32x16 osel[2];
#pragma unroll
  for (int db = 0; db < 2; ++db)
#pragma unroll
    for (int r = 0; r < 16; ++r) osel[db][r] = 0.f;
  float msel = 0.f, lsel = 0.f;
  {
    const bf16_t* kg = proj + (size_t)(36 + hkv) * SLOT + tokbase * 64;
    const bf16_t* vg = proj + (size_t)(38 + hkv) * SLOT + tokbase * 64;
    auto nextj = [&](int j) { if (j < 0 || j >= 31) return -1; const unsigned rest = umask & ~((2u << j) - 1u); return rest ? (int)__builtin_ctz(rest) : -1; };
    int j0 = __builtin_ctz(umask), j1 = nextj(j0);
    int b0 = 0; bool first = true;
    N_STAGE(kg, vg, 0, j0);
    if (j1 >= 0) N_STAGE(kg, vg, 1, j1);
    N_WAIT(j1 >= 0);
    while (true) {
      const int j2 = nextj(j1);
      const int b2 = b0 == 0 ? 2 : b0 - 1;
      if (j2 >= 0) N_STAGE(kg, vg, b2, j2);
      AdjSel adj{btab + (NSA_M0 - (qpos - j0 * 64 - 4 * hi)) * 4, t0 - (j0 * 64 + 63) >= 128, ((selm >> j0) & 1u) != 0, bfar};
      flash_tile<2>(L + b0 * NSA_TILE, L + b0 * NSA_TILE + 8192, q, osel, msel, lsel, wscr, lane, adj, first);
      first = false;
      N_WAIT(j2 >= 0);
      if (j1 < 0) break;
      j0 = j1; j1 = j2; b0 = b0 == 2 ? 0 : b0 + 1;
    }
  }
  lsel = xor32_sum(lsel);
  if (hi == 0) lds_wf(wscr + 128 + r32 * 4, 1.f / ((1.f + __expf(-gl[1])) * lsel));
#pragma unroll
  for (int r = 0; r < 16; ++r) {
    const float a1 = lds_rf(wscr + hi * 16 + 128 + crow0(r) * 4);
#pragma unroll
    for (int db = 0; db < 2; ++db) { res[db][r] += a1 * osel[db][r]; asm volatile("" : "+v"(res[db][r])); }
  }
  f32x16 owin[2];
#pragma unroll
  for (int db = 0; db < 2; ++db)
#pragma unroll
    for (int r = 0; r < 16; ++r) owin[db][r] = 0.f;
  float mwin = 0.f, lwin = 0.f;
  {
    const bf16_t* kg = proj + (size_t)(40 + hkv) * SLOT + tokbase * 64;
    const bf16_t* vg = proj + (size_t)(42 + hkv) * SLOT + tokbase * 64;
    const int jlo = (t0 - 511) > 0 ? (t0 - 511) >> 6 : 0, jhi = (t0 + 31) >> 6;
    int b0 = 0;
    N_STAGE(kg, vg, 0, jlo);
    if (jlo < jhi) N_STAGE(kg, vg, 1, jlo + 1);
    N_WAIT(jlo < jhi);
    for (int j = jlo; j <= jhi; ++j) {
      const int b2 = b0 == 0 ? 2 : b0 - 1;
      if (j + 2 <= jhi) N_STAGE(kg, vg, b2, j + 2);
      AdjWin adj{btab + (NSA_M0 - (qpos - j * 64 - 4 * hi)) * 4, (t0 - (j * 64 + 63) >= 128) && (t0 + 31 - j * 64 <= 511), bfar};
      flash_tile<2>(L + b0 * NSA_TILE, L + b0 * NSA_TILE + 8192, q, owin, mwin, lwin, wscr, lane, adj, j == jlo);
      N_WAIT(j + 2 <= jhi);
      b0 = b0 == 2 ? 0 : b0 + 1;
    }
  }
#undef N_STAGE
#undef N_WAIT
  lwin = xor32_sum(lwin);
  if (hi == 0) lds_wf(wscr + 128 + r32 * 4, 1.f / ((1.f + __expf(-gl[2])) * lwin));
  bf16_t* op = (bf16_t*)(ws + OFF_ATT) + (tokbase + t0 + 4 * hi) * DM + 512 + hq * 64 + r32;
#pragma unroll
  for (int r = 0; r < 16; ++r) {
    const float a2 = lds_rf(wscr + hi * 16 + 128 + crow0(r) * 4);
#pragma unroll
    for (int db = 0; db < 2; ++db) op[crow0(r) * DM + db * 32] = f2bf(res[db][r] + a2 * owin[db][r]);
  }
  __syncthreads();
}
constexpr int T3_END = 2048;
DI void phase3(const Params& p, lptr L, int wv, int bid, int nb) {
  for (int r = 0; r * nb < T3_END; ++r) {
    const int t = r * nb + ((r & 1) ? nb - 1 - bid : bid);
    if (t >= T3_END) continue;
    const int qt = 63 - (t >> 5), bh = t & 31;
    nsa_task(p, L, wv, bh >> 1, bh & 1, qt, t);
  }
}

constexpr int T4_END = 256 * 8;
DI void phase4(const Params& p, lptr L, int wv, int bid, int nb) {
  char* ws = p.ws;
  for_each_tile_patched(bid, nb, 256, 8, [&](int mt, int nt) {
    EpiResid e{p.x, (bf16_t*)(ws + OFF_STASH)};
    gemm_tile((const bf16_t*)(ws + OFF_ATT), DM, (const bf16_t*)(ws + OFF_WOUTT), DM, DM, mt * 128, nt * 128, L, wv, e);
  });
}
DI void rmsnorm_row_b2b(const bf16_t* __restrict__ xr, const float* __restrict__ g, bf16_t* __restrict__ o, int lane) {
  u32x2 v[4]; float f[16]; float ss = 0.f;
#pragma unroll
  for (int i = 0; i < 4; ++i) { v[i] = *(const u32x2*)(xr + lane * 4 + 256 * i); f[4 * i] = bflo(v[i][0]); f[4 * i + 1] = bfhi(v[i][0]); f[4 * i + 2] = bflo(v[i][1]); f[4 * i + 3] = bfhi(v[i][1]); }
#pragma unroll
  for (int i = 0; i < 16; ++i) ss += f[i] * f[i];
  ss = wave_sum(ss);
  const float rs = rsqrtf(ss * (1.f / 1024.f) + 1e-6f);
#pragma unroll
  for (int i = 0; i < 4; ++i) {
    f32x4 gg = *(const f32x4*)(g + lane * 4 + 256 * i);
    *(u32x2*)(o + lane * 4 + 256 * i) = (u32x2){cvtpk(f[4 * i] * rs * gg[0], f[4 * i + 1] * rs * gg[1]), cvtpk(f[4 * i + 2] * rs * gg[2], f[4 * i + 3] * rs * gg[3])};
  }
}
DI void phase5(const Params& p, lptr L, int wv, int bid, int nb) {
  for (int t = bid; t < NTOK / 4; t += nb) {
    const int tid = task_tid(wv);
    const int row = t * 4 + wv;
    rmsnorm_row_b2b((const bf16_t*)(p.ws + OFF_STASH) + (size_t)row * DM, p.g_ffn, (bf16_t*)(p.ws + OFF_XN) + (size_t)row * DM, tid & 63);
  }
}
constexpr int T6_END = 256 * 16;
DI void phase6(const Params& p, lptr L, int wv, int bid, int nb) {
  char* ws = p.ws;
  for_each_tile_patched(bid, nb, 256, 16, [&](int mt, int nt) {
    EpiBf16 e{(bf16_t*)(ws + OFF_PROJ), 2048, 2048};
    gemm_tile((const bf16_t*)(ws + OFF_XN), DM, (const bf16_t*)(ws + OFF_WPT), DM, DM, mt * 128, nt * 128, L, wv, e);
  });
}

DI unsigned fkey(float f) { unsigned u = __float_as_uint(f); return (u & 0x80000000u) ? ~u : (u | 0x80000000u); }
DI float unfkey(unsigned k) { return __uint_as_float((k & 0x80000000u) ? (k & 0x7fffffffu) : ~k); }
DI void ins16(unsigned (&Lst)[16], unsigned x) {
#pragma unroll
  for (int i = 0; i < 16; ++i) { const unsigned t = Lst[i] > x ? Lst[i] : x; x = Lst[i] > x ? x : Lst[i]; Lst[i] = t; }
}
DI unsigned pack_bf(unsigned s16, int n) {
  const unsigned k = (s16 & 0x8000u) ? (~s16 & 0xffffu) : (s16 | 0x8000u);
  return (k << 16) | (unsigned)(127 - n);
}
DI float unpack_bf(unsigned pk) {
  const unsigned k = pk >> 16;
  const unsigned s = (k & 0x8000u) ? (k & 0x7fffu) : (~k & 0xffffu);
  return __uint_as_float(s << 16);
}
DI void cx_desc(unsigned& hi_, unsigned& lo_) { const unsigned a = hi_ > lo_ ? hi_ : lo_, b = hi_ > lo_ ? lo_ : hi_; hi_ = a; lo_ = b; }
DI void bitonic_merge16_desc(unsigned (&a)[16]) {
#pragma unroll
  for (int j = 8; j > 0; j >>= 1)
#pragma unroll
    for (int i = 0; i < 16; ++i) { const int l = i ^ j; if (l > i) cx_desc(a[i], a[l]); }
}
DI void bitonic_sort16_desc(unsigned (&a)[16]) {
#pragma unroll
  for (int k = 2; k <= 16; k <<= 1)
#pragma unroll
    for (int j = k >> 1; j > 0; j >>= 1)
#pragma unroll
      for (int i = 0; i < 16; ++i) {
        const int l = i ^ j;
        if (l > i) { if ((i & k) == 0) cx_desc(a[i], a[l]); else cx_desc(a[l], a[i]); }
      }
}
DI void cxp_desc(unsigned& kh, unsigned& ph, unsigned& kl, unsigned& pl) {
  const bool gt = kh > kl;
  const unsigned a = gt ? kh : kl, b = gt ? kl : kh, pa = gt ? ph : pl, pb = gt ? pl : ph;
  kh = a; kl = b; ph = pa; pl = pb;
}
DI void bitonic_merge16p_desc(unsigned (&a)[16], unsigned (&q)[16]) {
#pragma unroll
  for (int j = 8; j > 0; j >>= 1)
#pragma unroll
    for (int i = 0; i < 16; ++i) { const int l = i ^ j; if (l > i) cxp_desc(a[i], q[i], a[l], q[l]); }
}
DI void bitonic_sort16p_desc(unsigned (&a)[16], unsigned (&q)[16]) {
#pragma unroll
  for (int k = 2; k <= 16; k <<= 1)
#pragma unroll
    for (int j = k >> 1; j > 0; j >>= 1)
#pragma unroll
      for (int i = 0; i < 16; ++i) {
        const int l = i ^ j;
        if (l > i) { if ((i & k) == 0) cxp_desc(a[i], q[i], a[l], q[l]); else cxp_desc(a[l], q[l], a[i], q[i]); }
      }
}
DI void top16_of_sorted_pair(unsigned (&a)[16], unsigned (&q)[16], const unsigned (&b)[16], const unsigned (&r)[16]) {
#pragma unroll
  for (int i = 0; i < 16; ++i) { const bool gt = a[i] > b[15 - i]; a[i] = gt ? a[i] : b[15 - i]; q[i] = gt ? q[i] : r[15 - i]; }
}
DI void top16_half(const u32x4 (&w)[16], unsigned (&Lst)[16]) {
#pragma unroll
  for (int g = 0; g < 8; ++g) {
    unsigned t[16];
#pragma unroll
    for (int e = 0; e < 4; ++e) {
      t[2 * e] = pack_bf(w[2 * g][e] & 0xffffu, g * 16 + 2 * e); t[2 * e + 1] = pack_bf(w[2 * g][e] >> 16, g * 16 + 2 * e + 1);
      t[8 + 2 * e] = pack_bf(w[2 * g + 1][e] & 0xffffu, g * 16 + 8 + 2 * e); t[8 + 2 * e + 1] = pack_bf(w[2 * g + 1][e] >> 16, g * 16 + 8 + 2 * e + 1);
    }
    bitonic_sort16_desc(t);
    if (g == 0) {
#pragma unroll
      for (int i = 0; i < 16; ++i) Lst[i] = t[i];
    } else {
#pragma unroll
      for (int i = 0; i < 16; ++i) Lst[i] = Lst[i] > t[15 - i] ? Lst[i] : t[15 - i];
      bitonic_merge16_desc(Lst);
    }
    __builtin_amdgcn_sched_barrier(0);
  }
}
DI void phase7(const Params& p, lptr L, int wv, int bid, int nb) {
  char* ws = p.ws;
  const int tid = task_tid(wv);
  const bf16_t* S = (const bf16_t*)(ws + OFF_PROJ);
  int* E = (int*)(ws + OFF_PEER_E); float* G = (float*)(ws + OFF_PEER_G);
  for (int task = bid * 256 + tid; task < NTOK * 8; task += nb * 256) {
    const bf16_t* srow = S + (size_t)task * 256;
    u32x4 wa[16], wb[16];
#pragma unroll
    for (int c = 0; c < 16; ++c) { wa[c] = *(const u32x4*)(srow + c * 8); wb[c] = *(const u32x4*)(srow + 128 + c * 8); }
    unsigned A[16], B[16];
    top16_half(wa, A);
    top16_half(wb, B);
    float av[16], bv[16];
#pragma unroll
    for (int i = 0; i < 16; ++i) { av[i] = unpack_bf(A[i]); bv[i] = unpack_bf(B[i]); }
#define CAND_K(i, j) ((fkey(av[i] + bv[j]) & 0xffffff00u) | (unsigned)(255 - ((i) * 16 + (j))))
#define CAND_P(i, j) ((127u - (A[i] & 127u)) * 128u + (127u - (B[j] & 127u)))
    unsigned CK[16], CP[16], DK[16], DP[16];
#pragma unroll
    for (int j = 0; j < 16; ++j) { CK[j] = CAND_K(0, j); CP[j] = CAND_P(0, j); }
    bitonic_sort16p_desc(CK, CP);
#pragma unroll
    for (int j = 0; j < 8; ++j) { DK[j] = CAND_K(1, j); DP[j] = CAND_P(1, j); }
#pragma unroll
    for (int j = 0; j < 5; ++j) { DK[8 + j] = CAND_K(2, j); DP[8 + j] = CAND_P(2, j); }
#pragma unroll
    for (int j = 0; j < 3; ++j) { DK[13 + j] = CAND_K(3, j); DP[13 + j] = CAND_P(3, j); }
    bitonic_sort16p_desc(DK, DP);
    top16_of_sorted_pair(CK, CP, DK, DP);
    bitonic_merge16p_desc(CK, CP);
    DK[0] = CAND_K(3, 3); DP[0] = CAND_P(3, 3);
#pragma unroll
    for (int j = 0; j < 3; ++j) { DK[1 + j] = CAND_K(4, j); DP[1 + j] = CAND_P(4, j); }
#pragma unroll
    for (int i = 5; i < 8; ++i) { DK[4 + 2 * (i - 5)] = CAND_K(i, 0); DP[4 + 2 * (i - 5)] = CAND_P(i, 0); DK[5 + 2 * (i - 5)] = CAND_K(i, 1); DP[5 + 2 * (i - 5)] = CAND_P(i, 1); }
#pragma unroll
    for (int i = 8; i < 14; ++i) { DK[10 + (i - 8)] = CAND_K(i, 0); DP[10 + (i - 8)] = CAND_P(i, 0); }
    bitonic_sort16p_desc(DK, DP);
#pragma unroll
    for (int i = 14; i < 16; ++i) {
      unsigned k = CAND_K(i, 0), pl = CAND_P(i, 0);
#pragma unroll
      for (int s2 = 0; s2 < 16; ++s2) cxp_desc(DK[s2], DP[s2], k, pl);
    }
    top16_of_sorted_pair(CK, CP, DK, DP);
#undef CAND_K
#undef CAND_P
    float cv[16], sm = 0.f;
    unsigned kmax = CK[0];
#pragma unroll
    for (int i = 1; i < 16; ++i) kmax = kmax > CK[i] ? kmax : CK[i];
    const float mx = unfkey(kmax & 0xffffff00u);
#pragma unroll
    for (int i = 0; i < 16; ++i) { cv[i] = __expf(unfkey(CK[i] & 0xffffff00u) - mx); sm += cv[i]; }
    const float inv = 1.f / sm;
    int* eo = E + (size_t)task * 16; float* go = G + (size_t)task * 16;
#pragma unroll
    for (int i = 0; i < 4; ++i) {
      *(u32x4*)(eo + 4 * i) = (u32x4){CP[4 * i], CP[4 * i + 1], CP[4 * i + 2], CP[4 * i + 3]};
      *(f32x4*)(go + 4 * i) = (f32x4){cv[4 * i] * inv, cv[4 * i + 1] * inv, cv[4 * i + 2] * inv, cv[4 * i + 3] * inv};
    }
  }
}

DI void dec16(const u32x2& w, float (&f)[16]) {
#pragma unroll
  for (int d = 0; d < 2; ++d) {
    const f32v2_t a = __builtin_amdgcn_cvt_scalef32_pk_f32_fp4(w[d], 1.0f, 0), b = __builtin_amdgcn_cvt_scalef32_pk_f32_fp4(w[d], 1.0f, 1);
    const f32v2_t c = __builtin_amdgcn_cvt_scalef32_pk_f32_fp4(w[d], 1.0f, 2), e = __builtin_amdgcn_cvt_scalef32_pk_f32_fp4(w[d], 1.0f, 3);
    f[8 * d] = a[0]; f[8 * d + 1] = a[1]; f[8 * d + 2] = b[0]; f[8 * d + 3] = b[1];
    f[8 * d + 4] = c[0]; f[8 * d + 5] = c[1]; f[8 * d + 6] = e[0]; f[8 * d + 7] = e[1];
  }
}
DI void phase8(const Params& p, lptr L, int wv, int bid, int nb, float* dst) {
  char* ws = p.ws;
  const int tid = task_tid(wv), lane = tid & 63, w = wv;
  const auto rsU = __builtin_amdgcn_make_buffer_rsrc((void*)(ws + OFF_U), 0, 8 << 20, 0x00020000);
  const auto rsV = __builtin_amdgcn_make_buffer_rsrc((void*)(ws + OFF_V), 0, 8 << 20, 0x00020000);
  const float* SU = (const float*)(ws + OFF_U + 16 * MiB); const float* SV = (const float*)(ws + OFF_V + 16 * MiB);
  const int* E = (const int*)(ws + OFF_PEER_E); const float* G = (const float*)(ws + OFF_PEER_G);
  for (int tok = bid * 4 + w; tok < NTOK; tok += nb * 4) {
    const bf16_t* xr = (const bf16_t*)(ws + OFF_XN) + (size_t)tok * DM + lane * 4;
    float xa[16];
#pragma unroll
    for (int i = 0; i < 4; ++i) { const u32x2 a = *(const u32x2*)(xr + 256 * i); xa[4 * i] = bflo(a[0]); xa[4 * i + 1] = bfhi(a[0]); xa[4 * i + 2] = bflo(a[1]); xa[4 * i + 3] = bfhi(a[1]); }
    float acc[16];
#pragma unroll
    for (int i = 0; i < 16; ++i) acc[i] = 0.f;
    const int e_lo = E[(size_t)tok * 128 + lane], e_hi = E[(size_t)tok * 128 + 64 + lane];
    const float g_lo = G[(size_t)tok * 128 + lane], g_hi = G[(size_t)tok * 128 + 64 + lane];
    const float su_lo = SU[e_lo], su_hi = SU[e_hi], sv_lo = SV[e_lo], sv_hi = SV[e_hi];
#pragma unroll 1
    for (int hb = 0; hb < 8; ++hb) {
      const int e = (hb & 4) ? e_hi : e_lo;
      const int l0 = (hb & 3) * 16;
      u32x2 ur[16], vr[16];
#pragma unroll
      for (int k = 0; k < 16; ++k) { const int ek = __builtin_amdgcn_readlane(e, l0 + k); ur[k] = __builtin_amdgcn_raw_buffer_load_b64(rsU, lane * 8, ek * 512, PEER_AUX); }
#pragma unroll
      for (int k = 0; k < 16; ++k) { const int ek = __builtin_amdgcn_readlane(e, l0 + k); vr[k] = __builtin_amdgcn_raw_buffer_load_b64(rsV, lane * 8, ek * 512, PEER_AUX); }
      const int src = (l0 + (lane >> 2)) * 4;
      const float gk = __uint_as_float(__builtin_amdgcn_ds_bpermute(src, __float_as_uint((hb & 4) ? g_hi : g_lo)));
      const float suk = __uint_as_float(__builtin_amdgcn_ds_bpermute(src, __float_as_uint((hb & 4) ? su_hi : su_lo)));
      const float svk = __uint_as_float(__builtin_amdgcn_ds_bpermute(src, __float_as_uint((hb & 4) ? sv_hi : sv_lo)));
      __builtin_amdgcn_sched_barrier(0);
      float dp[16];
#pragma unroll
      for (int k = 0; k < 16; ++k) {
        float f[16]; dec16(ur[k], f);
        float s0 = 0.f, s1 = 0.f;
#pragma unroll
        for (int i = 0; i < 8; ++i) { s0 += xa[2 * i] * f[2 * i]; s1 += xa[2 * i + 1] * f[2 * i + 1]; }
        dp[k] = s0 + s1;
      }
      __builtin_amdgcn_sched_barrier(0);
      float t8[8], t4[4], t2[2], z;
      { const bool b = (lane & 32) != 0;
#pragma unroll
        for (int i = 0; i < 8; ++i) { const float snd = b ? dp[i] : dp[i + 8], kp = b ? dp[i + 8] : dp[i]; t8[i] = kp + __shfl_xor(snd, 32); } }
      { const bool b = (lane & 16) != 0;
#pragma unroll
        for (int i = 0; i < 4; ++i) { const float snd = b ? t8[i] : t8[i + 4], kp = b ? t8[i + 4] : t8[i]; t4[i] = kp + __shfl_xor(snd, 16); } }
      { const bool b = (lane & 8) != 0;
#pragma unroll
        for (int i = 0; i < 2; ++i) { const float snd = b ? t4[i] : t4[i + 2], kp = b ? t4[i + 2] : t4[i]; t2[i] = kp + __shfl_xor(snd, 8); } }
      { const bool b = (lane & 4) != 0; const float snd = b ? t2[0] : t2[1], kp = b ? t2[1] : t2[0]; z = kp + __shfl_xor(snd, 4); }
      z += __shfl_xor(z, 2); z += __shfl_xor(z, 1);
      const float wgt = gk * gelu_tanh(z * suk) * svk;
      __builtin_amdgcn_sched_barrier(0);
#pragma unroll
      for (int k = 0; k < 16; ++k) {
        const float wk = __uint_as_float(__builtin_amdgcn_readlane(__float_as_uint(wgt), 4 * k));
        float f[16]; dec16(vr[k], f);
#pragma unroll
        for (int i = 0; i < 16; ++i) acc[i] += wk * f[i];
      }
    }
    const bf16_t* orow = (const bf16_t*)(ws + OFF_STASH) + (size_t)tok * DM + lane * 4;
    float* drow = dst + (size_t)tok * DM + lane * 4;
    float ss = 0.f;
#pragma unroll
    for (int i = 0; i < 4; ++i) {
      const u32x2 ab = *(const u32x2*)(orow + 256 * i);
      const f32x4 a = {bflo(ab[0]), bfhi(ab[0]), bflo(ab[1]), bfhi(ab[1])};
#pragma unroll
      for (int k = 0; k < 4; ++k) { acc[4 * i + k] += a[k]; ss += acc[4 * i + k] * acc[4 * i + k]; }
    }
    ss = wave_sum(ss);
    const float rs = rsqrtf(ss * (1.f / 1024.f) + 1e-6f);
    const float* gf = p.g_fin + lane * 4;
#pragma unroll
    for (int i = 0; i < 4; ++i) {
      f32x4 gg = *(const f32x4*)(gf + 256 * i), a;
#pragma unroll
      for (int k = 0; k < 4; ++k) a[k] = acc[4 * i + k] * rs * gg[k];
      *(f32x4*)(drow + 256 * i) = a;
    }
  }
}

#define XB_TMO      128
#define XB_XCNT(j)  (256  + 64 * (j))
#define XB_XSUB(j)  (1280 + 64 * (j))
#define XB_XGEN(j)  (2304 + 64 * (j))
#define XB_TOP      3328
#define XB_TOPGEN   3392
#define XCD_BAR_WORDS 3456
#define XB_SPIN_CAP (1u << 22)
#define LAS __attribute__((address_space(3)))
DI unsigned xb_ld(unsigned* p)              { return __hip_atomic_load(p, __ATOMIC_RELAXED, __HIP_MEMORY_SCOPE_AGENT); }
DI unsigned xb_add(unsigned* p, unsigned v) { return __hip_atomic_fetch_add(p, v, __ATOMIC_RELAXED, __HIP_MEMORY_SCOPE_AGENT); }
DI unsigned xb_xcc_id() { return (unsigned)__builtin_amdgcn_s_getreg((3 << 11) | 20) & 0xFu; }
#define XB_SPIN(cond, bar) do { unsigned _sp = 0; while (cond) { __builtin_amdgcn_s_sleep(1); \
    if ((++_sp & 255u) == 0u) { if (xb_ld(&(bar)[XB_TMO])) break; if (_sp > XB_SPIN_CAP) { atomicAdd(&(bar)[XB_TMO], 1u); break; } } } } while (0)
struct XcdBarrier { unsigned* bar; unsigned x; volatile LAS unsigned* st; };
DI XcdBarrier xcd_barrier_post(unsigned* bar, volatile LAS unsigned* st) {
  XcdBarrier b; b.bar = bar; b.x = xb_xcc_id(); b.st = st;
  if (threadIdx.x == 0) (void)xb_add(&bar[XB_XCNT(b.x)], 1u);
  return b;
}
DI void xcd_barrier_complete(unsigned* bar, unsigned x, unsigned& nloc, unsigned& nx) {
  const unsigned G = gridDim.x * gridDim.y * gridDim.z;
  unsigned sum, cnt, mine, sp = 0u;
  for (;;) {
    sum = 0u; cnt = 0u; mine = 0u;
#pragma unroll
    for (unsigned j = 0; j < 16; ++j) { const unsigned c = xb_ld(&bar[XB_XCNT(j)]); sum += c; cnt += (c > 0u) ? 1u : 0u; mine = (j == x) ? c : mine; }
    if (sum == G) break;
    __builtin_amdgcn_s_sleep(1);
    if ((++sp & 255u) == 0u) { if (xb_ld(&bar[XB_TMO])) break; if (sp > XB_SPIN_CAP) { atomicAdd(&bar[XB_TMO], 1u); break; } }
  }
  nloc = mine > 0u ? mine : 1u; nx = cnt > 0u ? cnt : 1u;
}
DI void xcd_barrier(const XcdBarrier& b) {
  asm volatile("s_waitcnt vmcnt(0)" ::: "memory");
  __syncthreads();
  if (threadIdx.x == 0) {
    unsigned* bar = b.bar;
    __builtin_amdgcn_s_waitcnt(0);
    unsigned nloc = b.st[0], nx = b.st[1];
    if (nloc == 0u) { xcd_barrier_complete(bar, b.x, nloc, nx); b.st[0] = nloc; b.st[1] = nx; }
    const unsigned old = xb_add(&bar[XB_XSUB(b.x)], 1u);
    const unsigned gen = old / nloc;
    if (old + 1u == (gen + 1u) * nloc) {
      __builtin_amdgcn_fence(__ATOMIC_RELEASE, "agent");
      asm volatile("s_waitcnt vmcnt(0)" ::: "memory");
      const unsigned og = xb_add(&bar[XB_TOP], 1u);
      const unsigned tg = og / nx;
      if (og + 1u == (tg + 1u) * nx) xb_add(&bar[XB_TOPGEN], 1u);
      else XB_SPIN(xb_ld(&bar[XB_TOPGEN]) == tg, bar);
      __builtin_amdgcn_fence(__ATOMIC_ACQUIRE, "agent");
      xb_add(&bar[XB_XGEN(b.x)], 1u);
      asm volatile("s_waitcnt vmcnt(0)" ::: "memory");
    } else {
      XB_SPIN(xb_ld(&bar[XB_XGEN(b.x)]) == gen, bar);
      __builtin_amdgcn_fence(__ATOMIC_ACQUIRE, "agent");
      asm volatile("s_waitcnt vmcnt(0)" ::: "memory");
    }
  }
  __syncthreads();
}

#if !MEGA
#define PHASE_KERNEL(name, fn) \
  __global__ void __launch_bounds__(256, 2) name(Params p) { \
    __shared__ __attribute__((aligned(16))) char lds_[LDS_BYTES]; \
    fn(p, (lptr)lds_, __builtin_amdgcn_readfirstlane(threadIdx.x >> 6), blockIdx.x, gridDim.x); }
PHASE_KERNEL(k_phase0, phase0)
PHASE_KERNEL(k_phase1, phase1)
PHASE_KERNEL(k_phase2, phase2)
PHASE_KERNEL(k_phase2b, phase2b)
PHASE_KERNEL(k_phase3, phase3)
PHASE_KERNEL(k_phase4, phase4)
PHASE_KERNEL(k_phase5, phase5)
PHASE_KERNEL(k_phase6, phase6)
PHASE_KERNEL(k_phase7, phase7)
__global__ void __launch_bounds__(256, 2) k_phase8(Params p) {
  __shared__ __attribute__((aligned(16))) char lds_[LDS_BYTES];
  phase8(p, (lptr)lds_, __builtin_amdgcn_readfirstlane(threadIdx.x >> 6), blockIdx.x, gridDim.x, p.out); }

__global__ void k_dbg_att(Params p) {
  const bf16_t* a = (const bf16_t*)(p.ws + OFF_ATT);
  for (size_t i = (size_t)blockIdx.x * 256 + threadIdx.x; i < (size_t)NTOK * DM; i += (size_t)gridDim.x * 256) p.out[i] = bf2f(a[i]);
}
#endif
#if MEGA
__global__ void __launch_bounds__(256, 2) k_mega(Params p) {
  __shared__ __attribute__((aligned(16))) char lds_[LDS_BYTES];
  cg::grid_group grid = cg::this_grid();
  lptr L = (lptr)lds_;
  const int bid = blockIdx.x, nb = gridDim.x, wv = __builtin_amdgcn_readfirstlane(threadIdx.x >> 6);
  volatile LAS unsigned* bst = (volatile LAS unsigned*)(L + LDS_BYTES - 16);
  if (threadIdx.x == 0) { bst[0] = 0u; bst[1] = 0u; bst[2] = 0u; bst[3] = 0u; }
  __syncthreads();
  const XcdBarrier xb = xcd_barrier_post((unsigned*)(p.ws + OFF_BAR), bst);
#define GSYNC() xcd_barrier(xb)
  if (p.ws == nullptr) grid.sync();
  phase0(p, L, wv, bid, nb); GSYNC();
#if DUP == 0
  phase0(p, L, wv, bid, nb); GSYNC();
#endif
  phase1(p, L, wv, bid, nb); GSYNC();
#if DUP == 1
  phase1(p, L, wv, bid, nb); GSYNC();
#endif
  phase2(p, L, wv, bid, nb); GSYNC();
#if DUP == 2
  phase2(p, L, wv, bid, nb); GSYNC();
#endif
  phase2b(p, L, wv, bid, nb); GSYNC();
  phase3(p, L, wv, bid, nb); GSYNC();
#if DUP == 3
  phase3(p, L, wv, bid, nb); GSYNC();
#endif
  phase4(p, L, wv, bid, nb); GSYNC();
#if DUP == 4
  phase4(p, L, wv, bid, nb); GSYNC();
#endif
  phase5(p, L, wv, bid, nb); GSYNC();
#if DUP == 5
  phase5(p, L, wv, bid, nb); GSYNC();
#endif
  phase6(p, L, wv, bid, nb); GSYNC();
#if DUP == 6
  phase6(p, L, wv, bid, nb); GSYNC();
#endif
  phase7(p, L, wv, bid, nb); GSYNC();
#if DUP == 7
  phase7(p, L, wv, bid, nb); GSYNC();
#endif
#if DUP == 8
  phase8(p, L, wv, bid, nb, (float*)(p.ws + OFF_PROJ)); GSYNC();
#endif
  phase8(p, L, wv, bid, nb, p.out);
}
#endif

extern "C" void kernel_launch(void* const* d_in, const int* in_sizes, int n_in, void* d_out, int out_size, void* d_ws, size_t ws_size, hipStream_t stream) {
  Params p{};
  const float** pp = (const float**)&p;
  for (int i = 0; i < 22; ++i) pp[i] = (const float*)d_in[i];
  p.out = (float*)d_out;
  p.ws = (char*)d_ws;
  if (ws_size < OFF_END) { fprintf(stderr, "kernel_launch: workspace too small (%zu < %zu)\n", ws_size, (size_t)OFF_END); return; }
#if MEGA
  static int grid_blocks = 0;
  if (!grid_blocks) {
    int dev = 0, cus = 0, per_cu = 0;
    hipGetDevice(&dev);
    hipDeviceGetAttribute(&cus, hipDeviceAttributeMultiprocessorCount, dev);
    hipOccupancyMaxActiveBlocksPerMultiprocessor(&per_cu, k_mega, 256, 0);
    if (per_cu > 2) per_cu = 2;
    if (per_cu < 1) per_cu = 1;
    grid_blocks = cus * per_cu;
  }
  hipMemsetAsync((char*)d_ws + OFF_BAR, 0, XCD_BAR_WORDS * 4, stream);
  void* args[] = {&p};
  hipError_t e = hipLaunchCooperativeKernel((void*)k_mega, dim3(grid_blocks), dim3(256), args, 0, stream);
  if (e != hipSuccess) fprintf(stderr, "cooperative launch failed: %s (grid %d)\n", hipGetErrorString(e), grid_blocks);
#else
  const int G = 1024;
#if DBG == 1
  k_phase0<<<G, 256, 0, stream>>>(p);
  k_phase1<<<G, 256, 0, stream>>>(p);
  k_phase2<<<G, 256, 0, stream>>>(p);
  k_phase2b<<<64, 256, 0, stream>>>(p);
  k_phase3<<<G, 256, 0, stream>>>(p);
  k_dbg_att<<<G, 256, 0, stream>>>(p);
  return;
#endif
  k_phase0<<<G, 256, 0, stream>>>(p);
  k_phase1<<<G, 256, 0, stream>>>(p);
  k_phase2<<<G, 256, 0, stream>>>(p);
  k_phase2b<<<64, 256, 0, stream>>>(p);
  k_phase3<<<G, 256, 0, stream>>>(p);
  k_phase4<<<G, 256, 0, stream>>>(p);
  k_phase5<<<G, 256, 0, stream>>>(p);
  k_phase6<<<G, 256, 0, stream>>>(p);
  k_phase7<<<G, 256, 0, stream>>>(p);
  k_phase8<<<G, 256, 0, stream>>>(p);
#endif
}
```

```cpp
#include <hip/hip_runtime.h>
#include <hip/hip_cooperative_groups.h>
#include <stdint.h>
#include <stdio.h>
namespace cg = cooperative_groups;

#ifndef MEGA
#define MEGA 1
#endif
#ifndef DBG
#define DBG 0
#endif
#ifndef PEER_AUX
#define PEER_AUX 0
#endif
#ifndef DUP
#define DUP -1
#endif

#define DI __device__ __forceinline__
typedef unsigned short bf16_t;
typedef __attribute__((ext_vector_type(8))) short bf16x8;
typedef __attribute__((ext_vector_type(4))) short s16x4;
typedef __attribute__((ext_vector_type(16))) float f32x16;
typedef __attribute__((ext_vector_type(4))) float f32x4;
typedef __attribute__((ext_vector_type(4))) unsigned u32x4;
typedef __attribute__((ext_vector_type(2))) unsigned u32x2;
typedef __attribute__((address_space(3))) char* lptr;
typedef const __attribute__((address_space(3))) char* lcptr;
typedef short v4i16_t __attribute__((ext_vector_type(4)));

constexpr int NTOK = 32768, DM = 1024, SEQ = 2048, NBATCH = 16;
constexpr size_t SLOT = (size_t)NTOK * 64;
constexpr float LOG2E = 1.4426950408889634f;
constexpr float QSCALE = 0.125f * LOG2E;
constexpr float NEGBIG = -1e30f;
constexpr float RTHR = 8.0f;
constexpr int LDS_BYTES = 73728;

constexpr size_t MiB = (size_t)1 << 20;
constexpr size_t OFF_XN = 0;
constexpr size_t OFF_PROJ = 64 * MiB;
constexpr size_t OFF_GATES = OFF_PROJ + 180 * MiB;
constexpr size_t OFF_ATT = OFF_GATES + 4 * MiB;
constexpr size_t OFF_WINT = OFF_ATT + 64 * MiB;
constexpr size_t OFF_WOUTT = OFF_WINT + 6 * MiB;
constexpr size_t OFF_WQB = OFF_WOUTT + 2 * MiB;
constexpr size_t OFF_SUBK = OFF_WQB + 4 * MiB;
constexpr size_t OFF_WPT = OFF_SUBK + 1 * MiB;
constexpr size_t OFF_U = OFF_WPT + 4 * MiB;
constexpr size_t OFF_V = OFF_U + 32 * MiB;
constexpr size_t OFF_W1KT = OFF_V + 32 * MiB;
constexpr size_t OFF_W1VT = OFF_W1KT + 1 * MiB;
constexpr size_t OFF_W2KT = OFF_W1VT + 1 * MiB;
constexpr size_t OFF_W2VT = OFF_W2KT + 64 * 1024;
constexpr size_t OFF_MISC = OFF_W2VT + 64 * 1024;
constexpr size_t OFF_HID = OFF_MISC + 64 * 1024;
constexpr size_t OFF_KCMP = OFF_HID + 4 * MiB;
constexpr size_t OFF_STASH = OFF_KCMP + 1 * MiB;
constexpr size_t OFF_BAR = OFF_STASH + 64 * MiB;
constexpr size_t OFF_END = OFF_BAR + 64 * 1024;
constexpr size_t OFF_PEER_E = OFF_ATT;
constexpr size_t OFF_PEER_G = OFF_ATT + 16 * MiB;

struct Params {
  const float *x, *w_in, *w_out, *g_mix, *g_ffn, *g_fin, *rel_bias, *lq1, *lk1, *lq2, *lk2, *subln;
  const float *pos_k, *pos_v, *w1k, *w2k, *w1v, *w2v, *wq, *subk, *pu, *pv;
  float* out;
  char* ws;
};

DI int crow(int r, int hi) { return (r & 3) + 8 * (r >> 2) + 4 * hi; }
DI constexpr int crow0(int r) { return (r & 3) + 8 * (r >> 2); }
typedef __bf16 bf16v2_t __attribute__((ext_vector_type(2)));
typedef float f32v2_t __attribute__((ext_vector_type(2)));
DI unsigned cvtpk(float lo, float hi) { return __builtin_bit_cast(unsigned, __builtin_convertvector((f32v2_t){lo, hi}, bf16v2_t)); }
DI bf16_t f2bf(float x) { return (bf16_t)(cvtpk(x, 0.f) & 0xffffu); }
DI float bf2f(bf16_t b) { return __uint_as_float((unsigned)b << 16); }
DI float bflo(unsigned w) { return __uint_as_float(w << 16); }
DI float bfhi(unsigned w) { return __uint_as_float(w & 0xffff0000u); }
#define MFMA32(a, b, c) __builtin_amdgcn_mfma_f32_32x32x16_bf16((a), (b), (c), 0, 0, 0)
DI bf16x8 lds_r128(lcptr p) { return *(const __attribute__((address_space(3))) bf16x8*)p; }
DI void lds_w128(lptr p, u32x4 v) { *(__attribute__((address_space(3))) u32x4*)p = v; }
DI float lds_rf(lcptr p) { return *(const __attribute__((address_space(3))) float*)p; }
DI void lds_wf(lptr p, float v) { *(__attribute__((address_space(3))) float*)p = v; }
DI unsigned lds_ru(lcptr p) { return *(const __attribute__((address_space(3))) unsigned*)p; }
DI void lds_wu(lptr p, unsigned v) { *(__attribute__((address_space(3))) unsigned*)p = v; }
DI s16x4 vtr(lcptr p) { return __builtin_bit_cast(s16x4, __builtin_amdgcn_ds_read_tr16_b64_v4i16((__attribute__((address_space(3))) v4i16_t*)p)); }
DI float wave_sum(float v) {
#pragma unroll
  for (int o = 32; o > 0; o >>= 1) v += __shfl_xor(v, o);
  return v;
}
DI float xor32_max(float m) { auto rr = __builtin_amdgcn_permlane32_swap(__float_as_uint(m), __float_as_uint(m), false, false); return fmaxf(__uint_as_float(rr[0]), __uint_as_float(rr[1])); }
DI float xor32_sum(float m) { auto rr = __builtin_amdgcn_permlane32_swap(__float_as_uint(m), __float_as_uint(m), false, false); return __uint_as_float(rr[0]) + __uint_as_float(rr[1]); }
DI float gelu_tanh(float x) { float y = 1.5957691216057308f * (x + 0.044715f * x * x * x); return x / (1.f + __expf(-y)); }
DI int lane_id() { return __builtin_amdgcn_mbcnt_hi(~0u, __builtin_amdgcn_mbcnt_lo(~0u, 0)); }
DI int task_tid(int wv) { int l; asm volatile("v_mbcnt_lo_u32_b32 %0, -1, 0\n\tv_mbcnt_hi_u32_b32 %0, -1, %0" : "=v"(l)); return wv * 64 + l; }
DI int mbcnt64(unsigned long long m) { return __builtin_amdgcn_mbcnt_hi((unsigned)(m >> 32), __builtin_amdgcn_mbcnt_lo((unsigned)m, 0)); }

DI void transpose_tile(const float* __restrict__ in, int N, bf16_t* __restrict__ out, int K, int tk, int tn, lptr L, int tid) {
#pragma unroll
  for (int i = 0; i < 16; ++i) {
    int e = tid + 256 * i, kk = e >> 6, nn = e & 63, n = tn * 64 + nn;
    float v = (n < N) ? in[(size_t)(tk * 64 + kk) * N + n] : 0.f;
    lds_wf(L + (kk * 65 + nn) * 4, v);
  }
  __syncthreads();
  const int nn = tid >> 2, kc = (tid & 3) * 16;
  unsigned w[8];
#pragma unroll
  for (int i = 0; i < 8; ++i) w[i] = cvtpk(lds_rf(L + ((kc + 2 * i) * 65 + nn) * 4), lds_rf(L + ((kc + 2 * i + 1) * 65 + nn) * 4));
  bf16_t* o = out + (size_t)(tn * 64 + nn) * K + tk * 64 + kc;
  *(u32x4*)o = (u32x4){w[0], w[1], w[2], w[3]};
  *(u32x4*)(o + 8) = (u32x4){w[4], w[5], w[6], w[7]};
  __syncthreads();
}
DI void convert_chunk(const float* __restrict__ in, bf16_t* __restrict__ out, size_t chunk, int tid) {
  size_t i = chunk * 2048 + (size_t)tid * 8;
  f32x4 a = *(const f32x4*)(in + i), b = *(const f32x4*)(in + i + 4);
  *(u32x4*)(out + i) = (u32x4){cvtpk(a[0], a[1]), cvtpk(a[2], a[3]), cvtpk(b[0], b[1]), cvtpk(b[2], b[3])};
}
DI void rmsnorm_rows4_bf16(const float* __restrict__ x0, const float* __restrict__ g, bf16_t* __restrict__ o0, int lane) {
  f32x4 v[4][4];
#pragma unroll
  for (int j = 0; j < 4; ++j)
#pragma unroll
    for (int i = 0; i < 4; ++i) v[j][i] = *(const f32x4*)(x0 + (size_t)j * DM + lane * 4 + 256 * i);
  f32x4 gg[4];
#pragma unroll
  for (int i = 0; i < 4; ++i) gg[i] = *(const f32x4*)(g + lane * 4 + 256 * i);
#pragma unroll
  for (int j = 0; j < 4; ++j) {
    float ss = 0.f;
#pragma unroll
    for (int i = 0; i < 4; ++i) ss += v[j][i][0] * v[j][i][0] + v[j][i][1] * v[j][i][1] + v[j][i][2] * v[j][i][2] + v[j][i][3] * v[j][i][3];
    ss = wave_sum(ss);
    const float rs = rsqrtf(ss * (1.f / 1024.f) + 1e-6f);
#pragma unroll
    for (int i = 0; i < 4; ++i)
      *(u32x2*)(o0 + (size_t)j * DM + lane * 4 + 256 * i) = (u32x2){cvtpk(v[j][i][0] * rs * gg[i][0], v[j][i][1] * rs * gg[i][1]), cvtpk(v[j][i][2] * rs * gg[i][2], v[j][i][3] * rs * gg[i][3])};
  }
}
DI void rmsnorm_row_bf16(const float* __restrict__ xr, const float* __restrict__ g, bf16_t* __restrict__ o, int lane) {
  f32x4 v[4]; float ss = 0.f;
#pragma unroll
  for (int i = 0; i < 4; ++i) { v[i] = *(const f32x4*)(xr + lane * 4 + 256 * i); ss += v[i][0] * v[i][0] + v[i][1] * v[i][1] + v[i][2] * v[i][2] + v[i][3] * v[i][3]; }
  ss = wave_sum(ss);
  const float rs = rsqrtf(ss * (1.f / 1024.f) + 1e-6f);
#pragma unroll
  for (int i = 0; i < 4; ++i) {
    f32x4 gg = *(const f32x4*)(g + lane * 4 + 256 * i);
    *(u32x2*)(o + lane * 4 + 256 * i) = (u32x2){cvtpk(v[i][0] * rs * gg[0], v[i][1] * rs * gg[1]), cvtpk(v[i][2] * rs * gg[2], v[i][3] * rs * gg[3])};
  }
}
DI void quant_row_fp4(const float* __restrict__ in, char* __restrict__ base, int row, int lane) {
  const float* r = in + (size_t)row * DM + lane * 4;
  f32x4 v[4]; float m = 0.f;
#pragma unroll
  for (int i = 0; i < 4; ++i) { v[i] = *(const f32x4*)(r + 256 * i); m = fmaxf(m, fmaxf(fmaxf(fabsf(v[i][0]), fabsf(v[i][1])), fmaxf(fabsf(v[i][2]), fabsf(v[i][3])))); }
#pragma unroll
  for (int o = 32; o > 0; o >>= 1) m = fmaxf(m, __shfl_xor(m, o));
  m = fmaxf(m, 1e-30f);
  const float sc = 6.f / m;
  unsigned w0 = 0u, w1 = 0u;
  w0 = __builtin_amdgcn_cvt_scalef32_pk_fp4_f32(w0, v[0][0] * sc, v[0][1] * sc, 1.0f, 0);
  w0 = __builtin_amdgcn_cvt_scalef32_pk_fp4_f32(w0, v[0][2] * sc, v[0][3] * sc, 1.0f, 1);
  w0 = __builtin_amdgcn_cvt_scalef32_pk_fp4_f32(w0, v[1][0] * sc, v[1][1] * sc, 1.0f, 2);
  w0 = __builtin_amdgcn_cvt_scalef32_pk_fp4_f32(w0, v[1][2] * sc, v[1][3] * sc, 1.0f, 3);
  w1 = __builtin_amdgcn_cvt_scalef32_pk_fp4_f32(w1, v[2][0] * sc, v[2][1] * sc, 1.0f, 0);
  w1 = __builtin_amdgcn_cvt_scalef32_pk_fp4_f32(w1, v[2][2] * sc, v[2][3] * sc, 1.0f, 1);
  w1 = __builtin_amdgcn_cvt_scalef32_pk_fp4_f32(w1, v[3][0] * sc, v[3][1] * sc, 1.0f, 2);
  w1 = __builtin_amdgcn_cvt_scalef32_pk_fp4_f32(w1, v[3][2] * sc, v[3][3] * sc, 1.0f, 3);
  *(u32x2*)(base + (size_t)row * 512 + lane * 8) = (u32x2){w0, w1};
  if (lane == 0) ((float*)(base + 16 * MiB))[row] = m * (1.f / 6.f);
}
DI void quant_rows4_fp4(const float* __restrict__ in, char* __restrict__ base, int row0, int lane) {
  f32x4 v[4][4];
#pragma unroll
  for (int j = 0; j < 4; ++j)
#pragma unroll
    for (int i = 0; i < 4; ++i) v[j][i] = *(const f32x4*)(in + (size_t)(row0 + j) * DM + lane * 4 + 256 * i);
#pragma unroll
  for (int j = 0; j < 4; ++j) {
    float m = 0.f;
#pragma unroll
    for (int i = 0; i < 4; ++i) m = fmaxf(m, fmaxf(fmaxf(fabsf(v[j][i][0]), fabsf(v[j][i][1])), fmaxf(fabsf(v[j][i][2]), fabsf(v[j][i][3]))));
#pragma unroll
    for (int o = 32; o > 0; o >>= 1) m = fmaxf(m, __shfl_xor(m, o));
    m = fmaxf(m, 1e-30f);
    const float sc = 6.f / m;
    unsigned w0 = 0u, w1 = 0u;
    w0 = __builtin_amdgcn_cvt_scalef32_pk_fp4_f32(w0, v[j][0][0] * sc, v[j][0][1] * sc, 1.0f, 0);
    w0 = __builtin_amdgcn_cvt_scalef32_pk_fp4_f32(w0, v[j][0][2] * sc, v[j][0][3] * sc, 1.0f, 1);
    w0 = __builtin_amdgcn_cvt_scalef32_pk_fp4_f32(w0, v[j][1][0] * sc, v[j][1][1] * sc, 1.0f, 2);
    w0 = __builtin_amdgcn_cvt_scalef32_pk_fp4_f32(w0, v[j][1][2] * sc, v[j][1][3] * sc, 1.0f, 3);
    w1 = __builtin_amdgcn_cvt_scalef32_pk_fp4_f32(w1, v[j][2][0] * sc, v[j][2][1] * sc, 1.0f, 0);
    w1 = __builtin_amdgcn_cvt_scalef32_pk_fp4_f32(w1, v[j][2][2] * sc, v[j][2][3] * sc, 1.0f, 1);
    w1 = __builtin_amdgcn_cvt_scalef32_pk_fp4_f32(w1, v[j][3][0] * sc, v[j][3][1] * sc, 1.0f, 2);
    w1 = __builtin_amdgcn_cvt_scalef32_pk_fp4_f32(w1, v[j][3][2] * sc, v[j][3][3] * sc, 1.0f, 3);
    *(u32x2*)(base + (size_t)(row0 + j) * 512 + lane * 8) = (u32x2){w0, w1};
    if (lane == 0) ((float*)(base + 16 * MiB))[row0 + j] = m * (1.f / 6.f);
  }
}
DI int t5_bucket(int n) {
  if (n < 16) return n;
  int b = 16 + (int)(logf((float)n * (1.f / 16.f)) / logf(8.f) * 16.f);
  return b > 31 ? 31 : b;
}
constexpr int T0_WIN = 16 * 46, T0_WOUT = 16 * 16, T0_W1 = 32 * 4, T0_W2 = 4 * 2;
constexpr int T0_A = 0, T0_B = T0_A + T0_WIN, T0_C = T0_B + T0_WOUT, T0_D = T0_C + T0_W1, T0_E = T0_D + T0_W1, T0_F = T0_E + T0_W2, T0_G = T0_F + T0_W2;
constexpr int T0_CVQ = 1024, T0_CVS = 128, T0_CVU = 1024;
constexpr int T0_H = T0_G + T0_CVQ, T0_I = T0_H + T0_CVS, T0_K = T0_I;
constexpr int T0_MISC = 33;
constexpr int T0_L = T0_K + T0_MISC;
constexpr int T0_NORM = NTOK / 16;
constexpr int T0_END = T0_L + T0_NORM;

DI void phase0(const Params& p, lptr L, int wv, int bid, int nb) {
  char* ws = p.ws;
  for (int t0_ = bid; t0_ < T0_END; t0_ += nb) {
    const int t = t0_ < T0_MISC ? T0_K + t0_ : (t0_ < T0_L ? t0_ - T0_MISC : t0_);
    const int tid = task_tid(wv);
    if (t < T0_B) { int q = t - T0_A; transpose_tile(p.w_in, 2840, (bf16_t*)(ws + OFF_WINT), 1024, q / 46, q % 46, L, tid); }
    else if (t < T0_C) { int q = t - T0_B; transpose_tile(p.w_out, 1024, (bf16_t*)(ws + OFF_WOUTT), 1024, q / 16, q % 16, L, tid); }
    else if (t < T0_D) { int q = t - T0_C; transpose_tile(p.w1k, 256, (bf16_t*)(ws + OFF_W1KT), 2048, q / 4, q % 4, L, tid); }
    else if (t < T0_E) { int q = t - T0_D; transpose_tile(p.w1v, 256, (bf16_t*)(ws + OFF_W1VT), 2048, q / 4, q % 4, L, tid); }
    else if (t < T0_F) { int q = t - T0_E; transpose_tile(p.w2k, 64, (bf16_t*)(ws + OFF_W2KT), 256, q / 2, q % 2, L, tid); }
    else if (t < T0_G) { int q = t - T0_F; transpose_tile(p.w2v, 64, (bf16_t*)(ws + OFF_W2VT), 256, q / 2, q % 2, L, tid); }
    else if (t < T0_H) convert_chunk(p.wq, (bf16_t*)(ws + OFF_WQB), t - T0_G, tid);
    else if (t < T0_I) convert_chunk(p.subk, (bf16_t*)(ws + OFF_SUBK), t - T0_H, tid);
    else if (t < T0_L) {
      int q = t - T0_K;
      float* misc = (float*)(ws + OFF_MISC);
      if (q < 32) {
        const int which = q >> 4, ch = q & 15;
        const float* pos = (which ? p.pos_v : p.pos_k) + ch * 128; const float* w1 = (which ? p.w1v : p.w1k) + (size_t)ch * 128 * 256;
        float a0 = 0.f, a1 = 0.f, a2 = 0.f, a3 = 0.f;
#pragma unroll 8
        for (int i = 0; i < 128; i += 4) {
          a0 += pos[i] * w1[(size_t)i * 256 + tid]; a1 += pos[i + 1] * w1[(size_t)(i + 1) * 256 + tid];
          a2 += pos[i + 2] * w1[(size_t)(i + 2) * 256 + tid]; a3 += pos[i + 3] * w1[(size_t)(i + 3) * 256 + tid];
        }
        misc[8192 + (which * 16 + ch) * 256 + tid] = (a0 + a1) + (a2 + a3);
      } else {
        float* btab = misc + 1024;
        for (int e = tid; e < 12 * 256; e += 256) { int h = e >> 8, rel = e & 255; btab[e] = p.rel_bias[t5_bucket(rel) * 12 + h] * LOG2E; }
        if (tid < 64) {
          float a = wave_sum(p.lq1[tid] * p.lk1[tid]), b = wave_sum(p.lq2[tid] * p.lk2[tid]);
          if (tid == 0) misc[512] = __expf(a) - __expf(b) + 0.2f;
        }
      }
    } else {
      const int row = (t - T0_L) * 16 + wv * 4;
      rmsnorm_rows4_bf16(p.x + (size_t)row * DM, p.g_mix, (bf16_t*)(ws + OFF_XN) + (size_t)row * DM, tid & 63);
    }
  }
}

DI void glds16(const bf16_t* g, lptr l) {
  __builtin_amdgcn_global_load_lds((const unsigned*)g, (__attribute__((address_space(3))) unsigned*)l, 16, 0, 0);
}
typedef decltype(__builtin_amdgcn_make_buffer_rsrc((void*)nullptr, 0, 0, 0)) rsrc_t;
DI rsrc_t make_rsrc(const void* p) { return __builtin_amdgcn_make_buffer_rsrc((void*)p, 0, 0x7fffffff, 0x00020000); }
DI void bdma16(rsrc_t r, unsigned voff, unsigned soff, lptr lbase) {
  __builtin_amdgcn_raw_ptr_buffer_load_lds(r, (__attribute__((address_space(3))) void*)lbase, 16, voff, soff, 0, 0);
}
template <class Epi>
DI void gemm_tile(const bf16_t* __restrict__ A, int lda, const bf16_t* __restrict__ Bt, int ldb, int K, int m0, int n0, lptr L, int wv, const Epi& epi) {
  const int tid = task_tid(wv);
  const int lane = tid & 63, w = tid >> 6, r32 = lane & 31, hi = lane >> 5;
  const int wm = w >> 1, wn = w & 1;
  const int srow = tid >> 3, sch = (tid & 7) ^ ((tid >> 4) & 7);
  const rsrc_t rA = make_rsrc(A), rB = make_rsrc(Bt);
  const unsigned voA = (unsigned)(srow * lda + sch * 8) * 2u, voB = (unsigned)(srow * ldb + sch * 8) * 2u;
  const unsigned soA = (unsigned)m0 * (unsigned)lda * 2u, soB = (unsigned)n0 * (unsigned)ldb * 2u;
  lptr Lw = L + wv * 1024;
  f32x16 acc[2][2];
#pragma unroll
  for (int i = 0; i < 2; ++i)
#pragma unroll
    for (int j = 0; j < 2; ++j)
#pragma unroll
      for (int r = 0; r < 16; ++r) acc[i][j][r] = 0.f;
#define G_STAGE(buf, k0) do { lptr d_ = Lw + (buf) * 32768; _Pragma("unroll") for (int i_ = 0; i_ < 4; ++i_) { \
      bdma16(rA, voA, soA + (unsigned)(32 * i_ * lda + (k0)) * 2u, d_ + i_ * 4096); bdma16(rB, voB, soB + (unsigned)(32 * i_ * ldb + (k0)) * 2u, d_ + 16384 + i_ * 4096); } } while (0)
  const int sw = (r32 >> 1) & 7;
  int co[4];
#pragma unroll
  for (int ks = 0; ks < 4; ++ks) co[ks] = (((2 * ks + hi) ^ sw) * 16);
  lcptr abase = L + (wm * 64 + r32) * 128, bbase = L + 16384 + (wn * 64 + r32) * 128;
  const int nk = K >> 6;
  G_STAGE(0, 0);
  asm volatile("s_waitcnt vmcnt(0)" ::: "memory");
  __syncthreads();
#define G_BODY(DMA) do { \
    lcptr a = abase + (kt & 1) * 32768, b = bbase + (kt & 1) * 32768; \
    lptr dn = Lw + ((kt + 1) & 1) * 32768; const int k1 = (kt + 1) * 64; \
    _Pragma("unroll") for (int ks = 0; ks < 4; ++ks) { \
      bf16x8 a0 = lds_r128(a + co[ks]), a1 = lds_r128(a + 32 * 128 + co[ks]); \
      bf16x8 b0 = lds_r128(b + co[ks]), b1 = lds_r128(b + 32 * 128 + co[ks]); \
      acc[0][0] = MFMA32(a0, b0, acc[0][0]); \
      if (DMA && ks < 2) bdma16(rA, voA, soA + (unsigned)(64 * ks * lda + k1) * 2u, dn + ks * 8192); \
      acc[0][1] = MFMA32(a0, b1, acc[0][1]); \
      if (DMA && ks < 2) bdma16(rB, voB, soB + (unsigned)(64 * ks * ldb + k1) * 2u, dn + 16384 + ks * 8192); \
      acc[1][0] = MFMA32(a1, b0, acc[1][0]); \
      if (DMA && ks < 2) bdma16(rA, voA, soA + (unsigned)((64 * ks + 32) * lda + k1) * 2u, dn + ks * 8192 + 4096); \
      acc[1][1] = MFMA32(a1, b1, acc[1][1]); \
      if (DMA && ks < 2) bdma16(rB, voB, soB + (unsigned)((64 * ks + 32) * ldb + k1) * 2u, dn + 16384 + ks * 8192 + 4096); \
    } \
    asm volatile("s_waitcnt vmcnt(0)" ::: "memory"); \
    __syncthreads(); } while (0)
  int kt = 0;
  for (; kt + 1 < nk; ++kt) G_BODY(1);
  G_BODY(0);
#undef G_BODY
#undef G_STAGE
  {
    lptr st = L + ((wm * 64 + 4 * hi) * 132 + wn * 64 + r32) * 4;
#pragma unroll
    for (int i = 0; i < 2; ++i)
#pragma unroll
      for (int j = 0; j < 2; ++j)
#pragma unroll
        for (int r = 0; r < 16; ++r) lds_wf(st + ((i * 32 + crow0(r)) * 132 + j * 32) * 4, acc[i][j][r]);
  }
  __syncthreads();
  {
    const int c4 = tid & 31, rr = tid >> 5;
#pragma unroll 4
    for (int it = 0; it < 16; ++it) {
      const int row = it * 8 + rr;
      const f32x4 v = *(const __attribute__((address_space(3))) f32x4*)(L + (row * 132 + c4 * 4) * 4);
      epi(m0 + row, n0 + c4 * 4, v);
    }
  }
  __syncthreads();
}

template <class F>
DI void for_each_tile_patched(int bid, int nb, int MT, int NT, const F& f) {
  if (nb == 512) {
    const int x = bid & 7, i = bid >> 3, pcols = (NT + 7) >> 3, npatch = (MT >> 3) * pcols;
    for (int pidx = x; pidx < npatch; pidx += 8) {
      const int mt = (pidx / pcols) * 8 + (i >> 3), nt = (pidx % pcols) * 8 + (i & 7);
      if (nt < NT) f(mt, nt);
    }
  } else {
    for (int t = bid; t < MT * NT; t += nb) f(t / NT, t % NT);
  }
}
struct EpiInProj {
  bf16_t* proj; float* gates;
  DI void operator()(int row, int col, const f32x4& v) const {
    if (col < 2816) {
      const int slot = col >> 6, d = col & 63;
      const float sc = (slot < 8 || (slot >= 24 && slot < 32)) ? QSCALE : 1.f;
      *(u32x2*)(proj + (size_t)slot * SLOT + (size_t)row * 64 + d) = (u32x2){cvtpk(v[0] * sc, v[1] * sc), cvtpk(v[2] * sc, v[3] * sc)};
    } else if (col < 2840) {
      *(f32x4*)(gates + (size_t)row * 24 + (col - 2816)) = v;
    }
  }
};
struct EpiBf16 {
  bf16_t* c; int ldc; int ncols;
  DI void operator()(int row, int col, const f32x4& v) const {
    if (col < ncols) *(u32x2*)(c + (size_t)row * ldc + col) = (u32x2){cvtpk(v[0], v[1]), cvtpk(v[2], v[3])};
  }
};
struct EpiGeluBias {
  bf16_t* c; int ldc; const float* cb;
  DI void operator()(int row, int col, const f32x4& v) const {
    f32x4 b = {0.f, 0.f, 0.f, 0.f};
#pragma unroll
    for (int i = 0; i < 16; ++i) { const f32x4 t = *(const f32x4*)(cb + i * 256 + col); b += t; }
    *(u32x2*)(c + (size_t)row * ldc + col) = (u32x2){cvtpk(gelu_tanh(v[0] + b[0]), gelu_tanh(v[1] + b[1])), cvtpk(gelu_tanh(v[2] + b[2]), gelu_tanh(v[3] + b[3]))};
  }
};
struct EpiResid {
  const float* x; bf16_t* o;
  DI void operator()(int row, int col, const f32x4& v) const {
    const size_t i = (size_t)row * DM + col;
    const f32x4 xv = *(const f32x4*)(x + i);
    *(u32x2*)(o + i) = (u32x2){cvtpk(xv[0] + v[0], xv[1] + v[1]), cvtpk(xv[2] + v[2], xv[3] + v[3])};
  }
};

constexpr int T1_IN = 256 * 23, T1_END = T1_IN + 128;
DI void phase1(const Params& p, lptr L, int wv, int bid, int nb) {
  char* ws = p.ws;
  for (int q = bid; q < 128; q += nb) {
    const int hp = q >> 3, dt = q & 7;
    EpiBf16 e{(bf16_t*)(ws + OFF_WPT) + (size_t)hp * 128 * DM, DM, DM};
    gemm_tile((const bf16_t*)(ws + OFF_SUBK) + (size_t)hp * 128 * 128, 128, (const bf16_t*)(ws + OFF_WQB) + hp * 128, 2048, 128, 0, dt * 128, L, wv, e);
  }
  for_each_tile_patched(bid, nb, 256, 23, [&](int mt, int nt) {
    EpiInProj e{(bf16_t*)(ws + OFF_PROJ), (float*)(ws + OFF_GATES)};
    gemm_tile((const bf16_t*)(ws + OFF_XN), DM, (const bf16_t*)(ws + OFF_WINT), DM, DM, mt * 128, nt * 128, L, wv, e);
  });
  for (int q = bid; q < 2 * T0_CVU; q += nb) {
    const int lane = task_tid(wv) & 63;
    if (q < T0_CVU) quant_rows4_fp4(p.pu, ws + OFF_U, q * 16 + wv * 4, lane);
    else quant_rows4_fp4(p.pv, ws + OFF_V, (q - T0_CVU) * 16 + wv * 4, lane);
  }
}

template <int NDB, class Adj>
DI void flash_tile(lcptr Kt, lcptr Vt, const bf16x8 (&q)[4], f32x16 (&o)[NDB], float& mref, float& lsum, lptr wsf, int lane, const Adj& adj, bool first) {
  const int r32 = lane & 31, hi = lane >> 5;
  const float c = adj.base() - mref;
  f32x16 p0, p1;
#pragma unroll
  for (int r = 0; r < 16; ++r) { p0[r] = c; p1[r] = c; }
  lcptr kp = Kt + r32 * 128;
  const int ksw = (r32 >> 1) & 7;
#pragma unroll
  for (int s = 0; s < 4; ++s) {
    const int kc = ((2 * s + hi) ^ ksw) * 16;
    bf16x8 k0 = lds_r128(kp + kc), k1 = lds_r128(kp + 32 * 128 + kc);
    p0 = MFMA32(k0, q[s], p0); p1 = MFMA32(k1, q[s], p1);
  }
  adj(p0, 0); adj(p1, 32);
  float rm = p0[0];
#pragma unroll
  for (int r = 1; r < 16; ++r) rm = fmaxf(rm, p0[r]);
#pragma unroll
  for (int r = 0; r < 16; ++r) rm = fmaxf(rm, p1[r]);
  rm = xor32_max(rm);
  if (__any(first || rm > RTHR)) {
    const float d = first ? fmaxf(rm, -1000.f) : fmaxf(rm, 0.f);
    const float f = first ? 1.f : __builtin_amdgcn_exp2f(-d);
    mref += d; lsum *= f;
    if (hi == 0) lds_wf(wsf + r32 * 4, f);
#pragma unroll
    for (int r = 0; r < 16; ++r) {
      const float fr = lds_rf(wsf + hi * 16 + crow0(r) * 4);
#pragma unroll
      for (int db = 0; db < NDB; ++db) o[db][r] *= fr;
    }
#pragma unroll
    for (int r = 0; r < 16; ++r) { p0[r] -= d; p1[r] -= d; }
  }
  float s = 0.f;
#pragma unroll
  for (int r = 0; r < 16; ++r) { p0[r] = __builtin_amdgcn_exp2f(p0[r]); p1[r] = __builtin_amdgcn_exp2f(p1[r]); s += p0[r] + p1[r]; }
  lsum += s;
  bf16x8 pw[4];
  pw[0] = __builtin_bit_cast(bf16x8, (u32x4){cvtpk(p0[0], p0[1]), cvtpk(p0[2], p0[3]), cvtpk(p0[4], p0[5]), cvtpk(p0[6], p0[7])});
  pw[1] = __builtin_bit_cast(bf16x8, (u32x4){cvtpk(p0[8], p0[9]), cvtpk(p0[10], p0[11]), cvtpk(p0[12], p0[13]), cvtpk(p0[14], p0[15])});
  pw[2] = __builtin_bit_cast(bf16x8, (u32x4){cvtpk(p1[0], p1[1]), cvtpk(p1[2], p1[3]), cvtpk(p1[4], p1[5]), cvtpk(p1[6], p1[7])});
  pw[3] = __builtin_bit_cast(bf16x8, (u32x4){cvtpk(p1[8], p1[9]), cvtpk(p1[10], p1[11]), cvtpk(p1[12], p1[13]), cvtpk(p1[14], p1[15])});
  lcptr vp = Vt + (4 * hi + ((lane & 15) >> 2)) * 64 + ((lane >> 4) & 1) * 32 + (lane & 3) * 8;
#pragma unroll
  for (int db = 0; db < NDB; ++db)
#pragma unroll
    for (int s4 = 0; s4 < 4; ++s4) {
      s16x4 lo = vtr(vp + db * 4096 + s4 * 1024), hh = vtr(vp + db * 4096 + s4 * 1024 + 512);
      bf16x8 vf = (bf16x8){lo[0], lo[1], lo[2], lo[3], hh[0], hh[1], hh[2], hh[3]};
      o[db] = MFMA32(pw[s4], vf, o[db]);
    }
}
DI void load_q(bf16x8 (&q)[4], const bf16_t* qrow, int hi) {
#pragma unroll
  for (int s = 0; s < 4; ++s) q[s] = *(const bf16x8*)(qrow + s * 16 + hi * 8);
}

struct AdjDiff {
  lcptr ab; bool far; float bfar;
  DI float base() const { return far ? bfar : 0.f; }
  DI void operator()(f32x16& p, int koff) const {
    if (!far) {
#pragma unroll
      for (int r = 0; r < 16; ++r) p[r] += lds_rf(ab + (koff + crow0(r)) * 4);
    }
  }
};
constexpr int DIFF_M0 = 224, DIFF_TM = 288;
constexpr int DIFF_BUF = 32768;
constexpr int DIFF_WSF = 2 * DIFF_BUF;
constexpr int DIFF_BTAB = DIFF_WSF + 1024;
DI void diff_task(const Params& p, lptr L, int wv, int b, int h, int qt) {
  char* ws = p.ws; asm volatile("" : "+s"(ws));
  const int tid = task_tid(wv);
  const int lane = tid & 63, w = tid >> 6, r32 = lane & 31, hi = lane >> 5;
  const int comp = w & 1, half = w >> 1;
  const bf16_t* proj = (const bf16_t*)(ws + OFF_PROJ);
  const float* misc = (const float*)(ws + OFF_MISC);
  const int t0 = qt * 64;
  const size_t tokbase = (size_t)b * SEQ;
  for (int m = tid; m < DIFF_TM; m += 256) { const int rel = DIFF_M0 - m; lds_wf(L + DIFF_BTAB + m * 4, rel < 0 ? NEGBIG : misc[1024 + h * 256 + (rel > 255 ? 255 : rel)]); }
  const float bfar = misc[1024 + h * 256 + 255];
  const int qpos = t0 + half * 32 + r32;
  bf16x8 q[4];
  load_q(q, proj + (size_t)(2 * h + comp) * SLOT + (tokbase + qpos) * 64, hi);
  f32x16 o[4];
#pragma unroll
  for (int db = 0; db < 4; ++db)
#pragma unroll
    for (int r = 0; r < 16; ++r) o[db][r] = 0.f;
  float mref = 0.f, lsum = 0.f;
  lptr wsf = L + DIFF_WSF + w * 256;
  const int NT = qt + 1;
  const bf16_t* k0g = proj + (size_t)(8 + 2 * h) * SLOT + tokbase * 64;
  const bf16_t* k1g = proj + (size_t)(9 + 2 * h) * SLOT + tokbase * 64;
  const bf16_t* v0g = proj + (size_t)(16 + 2 * h) * SLOT + tokbase * 64;
  const bf16_t* v1g = proj + (size_t)(17 + 2 * h) * SLOT + tokbase * 64;
  const int krow = tid >> 3, kch = (tid & 7) ^ ((tid >> 4) & 7);
  const int vkey = tid >> 2, vc = tid & 3;
  const rsrc_t rk0 = make_rsrc(k0g), rk1 = make_rsrc(k1g), rv0 = make_rsrc(v0g), rv1 = make_rsrc(v1g);
  const unsigned kvo = (unsigned)(krow * 64 + kch * 8) * 2u, vvo = (unsigned)(vkey * 64 + vc * 8) * 2u;
  lptr Lw = L + wv * 1024;
#define D_STAGE(buf, j) do { const unsigned so_ = (unsigned)(j) * 8192u; lptr b_ = Lw + (buf) * DIFF_BUF; \
      bdma16(rk0, kvo, so_, b_); bdma16(rk0, kvo, so_ + 4096u, b_ + 4096); \
      bdma16(rk1, kvo, so_, b_ + 8192); bdma16(rk1, kvo, so_ + 4096u, b_ + 12288); \
      bdma16(rv0, vvo, so_, b_ + 16384); bdma16(rv0, vvo, so_ + 64u, b_ + 20480); \
      bdma16(rv1, vvo, so_, b_ + 24576); bdma16(rv1, vvo, so_ + 64u, b_ + 28672); } while (0)
  D_STAGE(0, 0);
  asm volatile("s_waitcnt vmcnt(0)" ::: "memory");
  __syncthreads();
  for (int j = 0; j < NT; ++j) {
    if (j + 1 < NT) D_STAGE((j + 1) & 1, j + 1);
    lcptr bufp = L + (j & 1) * DIFF_BUF;
    AdjDiff adj{L + DIFF_BTAB + (DIFF_M0 - (qpos - j * 64 - 4 * hi)) * 4, (t0 + half * 32) - (j * 64 + 63) >= 128, bfar};
    flash_tile<4>(bufp + comp * 8192, bufp + 16384, q, o, mref, lsum, wsf, lane, adj, j == 0);
    asm volatile("s_waitcnt vmcnt(0)" ::: "memory");
    __syncthreads();
  }
#undef D_STAGE
  lsum = xor32_sum(lsum);
  if (hi == 0) lds_wf(wsf + r32 * 4, 1.f / lsum);
  float il[16];
#pragma unroll
  for (int r = 0; r < 16; ++r) il[r] = lds_rf(wsf + hi * 16 + crow0(r) * 4);
  const float lam = misc[512];
  lptr X = L;
  lptr Xb = X + ((half * 32 + 4 * hi) * 132 + r32) * 4;
  if (comp == 1) {
#pragma unroll
    for (int db = 0; db < 4; ++db)
#pragma unroll
      for (int r = 0; r < 16; ++r) lds_wf(Xb + (crow0(r) * 132 + db * 32) * 4, o[db][r] * il[r] * lam);
  }
  __syncthreads();
  if (comp == 0) {
#pragma unroll
    for (int db = 0; db < 4; ++db)
#pragma unroll
      for (int r = 0; r < 16; ++r) {
        lptr a = Xb + (crow0(r) * 132 + db * 32) * 4;
        lds_wf(a, o[db][r] * il[r] - lds_rf(a));
      }
  }
  __syncthreads();
  {
    const int tok = tid >> 2, part = tid & 3;
    float v[32]; float ss = 0.f;
#pragma unroll
    for (int i = 0; i < 32; ++i) { v[i] = lds_rf(X + (tok * 132 + part * 32 + i) * 4); ss += v[i] * v[i]; }
    ss += __shfl_xor(ss, 1); ss += __shfl_xor(ss, 2);
    const float rs = rsqrtf(ss * (1.f / 128.f) + 1e-6f) * 0.8f;
    const float* g = p.subln + part * 32;
    bf16_t* op = (bf16_t*)(ws + OFF_ATT) + (tokbase + t0 + tok) * DM + h * 128 + part * 32;
#pragma unroll
    for (int i = 0; i < 4; ++i) {
      u32x4 wv;
#pragma unroll
      for (int k = 0; k < 4; ++k) wv[k] = cvtpk(v[i * 8 + 2 * k] * rs * g[i * 8 + 2 * k], v[i * 8 + 2 * k + 1] * rs * g[i * 8 + 2 * k + 1]);
      *(u32x4*)(op + i * 8) = wv;
    }
  }
  __syncthreads();
}
constexpr int T2_CMP = 2 * 32 * 2, T2_DIFF = 2048, T2_END = T2_CMP + T2_DIFF;
DI void phase2(const Params& p, lptr L, int wv, int bid, int nb) {
  char* ws = p.ws;
  for (int t = bid; t < T2_END; t += nb) {
    if (t < T2_CMP) {
      const int which = t >> 6, mt = (t >> 1) & 31, nt = t & 1;
      EpiGeluBias e{(bf16_t*)(ws + OFF_HID) + (size_t)which * 4096 * 256, 256, (const float*)(ws + OFF_MISC) + 8192 + which * 16 * 256};
      gemm_tile((const bf16_t*)(ws + OFF_PROJ) + (size_t)(32 + 2 * which) * SLOT, 1024, (const bf16_t*)(ws + (which ? OFF_W1VT : OFF_W1KT)), 2048, 2048, mt * 128, nt * 128, L, wv, e);
    } else {
      const int q = t - T2_CMP, qt = 31 - (q >> 6), bh = q & 63;
      diff_task(p, L, wv, bh >> 2, bh & 3, qt);
    }
  }
}
constexpr int T2B_END = 2 * 32;
DI void phase2b(const Params& p, lptr L, int wv, int bid, int nb) {
  char* ws = p.ws;
  for (int t = bid; t < T2B_END; t += nb) {
    const int which = t >> 5, mt = t & 31;
    EpiBf16 e{(bf16_t*)(ws + OFF_KCMP) + (size_t)which * 4096 * 64, 64, 64};
    gemm_tile((const bf16_t*)(ws + OFF_HID) + (size_t)which * 4096 * 256, 256, (const bf16_t*)(ws + (which ? OFF_W2VT : OFF_W2KT)), 256, 256, mt * 128, 0, L, wv, e);
  }
}

constexpr int NSA_TILE = 16384;
constexpr int NSA_PSUM = 34816;
constexpr int NSA_SC = NSA_PSUM + 16512;
constexpr int NSA_SELM = NSA_SC + 4608;
constexpr int NSA_WSF = NSA_SELM + 128;
constexpr int NSA_BTAB = NSA_WSF + 4096;
struct AdjSel {
  lcptr ab; bool far; bool on; float bfar;
  DI float base() const { return on ? (far ? bfar : 0.f) : NEGBIG; }
  DI void operator()(f32x16& p, int koff) const {
    if (!far) {
#pragma unroll
      for (int r = 0; r < 16; ++r) p[r] += lds_rf(ab + (koff + crow0(r)) * 4);
    }
  }
};
struct AdjWin {
  lcptr ab; bool mid; float bfar;
  DI float base() const { return mid ? bfar : 0.f; }
  DI void operator()(f32x16& p, int koff) const {
    if (!mid) {
#pragma unroll
      for (int r = 0; r < 16; ++r) p[r] += lds_rf(ab + (koff + crow0(r)) * 4);
    }
  }
};
constexpr int NSA_M0 = 608, NSA_TM = 672;
static_assert(NSA_BTAB + 4 * NSA_TM * 4 <= LDS_BYTES - 16, "nsa lds");
DI void nsa_task(const Params& p, lptr L, int wv, int b, int hkv, int qt, int task) {
  char* ws = p.ws; asm volatile("" : "+s"(ws));
  const int tid = task_tid(wv);
  const int lane = tid & 63, w = tid >> 6, r32 = lane & 31, hi = lane >> 5;
  const bf16_t* proj = (const bf16_t*)(ws + OFF_PROJ);
  const float* misc = (const float*)(ws + OFF_MISC);
  const int t0 = qt * 32, hq = hkv * 4 + w;
  const size_t tokbase = (size_t)b * SEQ;
  const int qpos = t0 + r32;
  const int cur = t0 >> 6;
  lptr wsf = L + NSA_WSF + w * 1024;
#pragma unroll
  for (int e = tid; e < 4 * NSA_TM; e += 256) {
    const int i = e / NSA_TM, rel = NSA_M0 - (e - i * NSA_TM);
    lds_wf(L + NSA_BTAB + e * 4, (rel < 0 || rel > 511) ? NEGBIG : misc[1024 + (4 + hkv * 4 + i) * 256 + (rel > 255 ? 255 : rel)]);
  }
  lcptr btab = L + NSA_BTAB + w * (NSA_TM * 4);
  const float bfar = misc[1024 + (4 + hq) * 256 + 255];
  bf16x8 q[4];
  load_q(q, proj + (size_t)(24 + hq) * SLOT + (tokbase + qpos) * 64, hi);
  const float* gl = (const float*)(ws + OFF_GATES) + (tokbase + qpos) * 24 + hq * 3;
  lptr wscr = wsf + 384;
  f32x16 res[2];

  {
    const bf16_t* kc = (const bf16_t*)(ws + OFF_KCMP) + (size_t)((hkv * 16 + b) * 128) * 64;
    const bf16_t* vc = kc + (size_t)4096 * 64;
    const int key0 = tid >> 3, ch = tid & 7;
    const bf16_t* kcp = kc + key0 * 64 + ch * 8; const bf16_t* vcp = vc + key0 * 64 + ch * 8;
    lptr kd = L + key0 * 128 + ((ch ^ ((key0 >> 1) & 7)) * 16), vd = L + 18432 + (ch >> 2) * 8192 + key0 * 64 + (ch & 3) * 16;
#pragma unroll
    for (int i = 0; i < 4; ++i) {
      u32x4 kk = *(const u32x4*)(kcp + i * 32 * 64), vv = *(const u32x4*)(vcp + i * 32 * 64);
      lds_w128(kd + i * 32 * 128, kk);
      lds_w128(vd + i * 32 * 64, vv);
    }
  }
  __syncthreads();
  {
    f32x16 ocmp[2];
    f32x16 pc[4];
#pragma unroll
    for (int kb = 0; kb < 4; ++kb) {
#pragma unroll
      for (int r = 0; r < 16; ++r) pc[kb][r] = 0.f;
      lcptr kp = L + (kb * 32 + r32) * 128;
#pragma unroll
      for (int s = 0; s < 4; ++s) pc[kb] = MFMA32(lds_r128(kp + (((2 * s + hi) ^ ((r32 >> 1) & 7)) * 16)), q[s], pc[kb]);
    }
    const int nvalid = qpos >= 31 ? ((qpos - 31) >> 4) + 1 : 0;
    const int nvh = nvalid - 4 * hi;
    float rm = NEGBIG;
#pragma unroll
    for (int kb = 0; kb < 4; ++kb)
#pragma unroll
      for (int r = 0; r < 16; ++r) { const bool ok = (kb * 32 + crow0(r)) < nvh; pc[kb][r] = ok ? pc[kb][r] : NEGBIG; rm = fmaxf(rm, pc[kb][r]); }
    rm = xor32_max(rm);
    float s = 0.f;
#pragma unroll
    for (int kb = 0; kb < 4; ++kb)
#pragma unroll
      for (int r = 0; r < 16; ++r) { pc[kb][r] = __builtin_amdgcn_exp2f(pc[kb][r] - rm); s += pc[kb][r]; }
    s = xor32_sum(s);
    const float inv = nvalid > 0 ? 1.f / s : 0.f;
#pragma unroll
    for (int kb = 0; kb < 4; ++kb)
#pragma unroll
      for (int r = 0; r < 16; ++r) pc[kb][r] *= inv;
#pragma unroll
    for (int db = 0; db < 2; ++db)
#pragma unroll
      for (int r = 0; r < 16; ++r) ocmp[db][r] = 0.f;
    lcptr vp = L + 18432 + (4 * hi + ((lane & 15) >> 2)) * 64 + ((lane >> 4) & 1) * 32 + (lane & 3) * 8;
#pragma unroll
    for (int s8 = 0; s8 < 8; ++s8) {
      const int kb = s8 >> 1, r0 = (s8 & 1) * 8;
      bf16x8 pw = __builtin_bit_cast(bf16x8, (u32x4){cvtpk(pc[kb][r0], pc[kb][r0 + 1]), cvtpk(pc[kb][r0 + 2], pc[kb][r0 + 3]), cvtpk(pc[kb][r0 + 4], pc[kb][r0 + 5]), cvtpk(pc[kb][r0 + 6], pc[kb][r0 + 7])});
#pragma unroll
      for (int db = 0; db < 2; ++db) {
        s16x4 lo = vtr(vp + db * 8192 + s8 * 1024), hh = vtr(vp + db * 8192 + s8 * 1024 + 512);
        bf16x8 vf = (bf16x8){lo[0], lo[1], lo[2], lo[3], hh[0], hh[1], hh[2], hh[3]};
        ocmp[db] = MFMA32(pw, vf, ocmp[db]);
      }
    }
    if (hi == 0) lds_wf(wscr + 128 + r32 * 4, 1.f / (1.f + __expf(-gl[0])));
#pragma unroll
    for (int r = 0; r < 16; ++r) {
      const float g0 = lds_rf(wscr + hi * 16 + 128 + crow0(r) * 4);
#pragma unroll
      for (int db = 0; db < 2; ++db) { res[db][r] = g0 * ocmp[db][r]; asm volatile("" : "+v"(res[db][r])); }
    }
#pragma nounroll
    for (int g = 0; g < 4; ++g) {
      if (w == g) {
#pragma unroll
        for (int kb = 0; kb < 4; ++kb)
#pragma unroll
          for (int r = 0; r < 16; ++r) {
            lptr a = L + NSA_PSUM + (r32 * 129 + 4 * hi) * 4 + (kb * 32 + crow0(r)) * 4;
            lds_wf(a, g == 0 ? pc[kb][r] : lds_rf(a) + pc[kb][r]);
          }
      }
      __syncthreads();
    }
  }
  {
    const int tok = tid >> 3, sub = tid & 7;
    lcptr ps = L + NSA_PSUM + tok * 129 * 4;
#pragma unroll
    for (int jj = 0; jj < 4; ++jj) {
      const int j = sub * 4 + jj;
      float imp = 2.f * (lds_rf(ps + (4 * j) * 4) + lds_rf(ps + (4 * j + 1) * 4) + lds_rf(ps + (4 * j + 2) * 4)) + lds_rf(ps + (4 * j + 3) * 4);
      if (j > 0) imp += lds_rf(ps + (4 * j - 1) * 4);
      const bool forced = (j == 0) || (j == cur) || (j == cur - 1);
      const float sc = (j <= cur) ? imp + (forced ? 1000.f : 0.f) : NEGBIG;
      lds_wf(L + NSA_SC + (tok * 36 + j) * 4, sc);
    }
  }
  __syncthreads();
  {
    const int tok = tid >> 3, sub = tid & 7;
    float sv[32];
#pragma unroll
    for (int c = 0; c < 8; ++c) {
      const f32x4 t4 = *(const __attribute__((address_space(3))) f32x4*)(L + NSA_SC + (tok * 36 + c * 4) * 4);
      sv[4 * c] = t4[0]; sv[4 * c + 1] = t4[1]; sv[4 * c + 2] = t4[2]; sv[4 * c + 3] = t4[3];
    }
    unsigned bits = 0;
#pragma unroll
    for (int jj = 0; jj < 4; ++jj) {
      float mine = sv[jj];
#pragma unroll
      for (int c = 1; c < 8; ++c) mine = (sub == c) ? sv[4 * c + jj] : mine;
      const int j = sub * 4 + jj;
      int rank = 0;
#pragma unroll
      for (int k = 0; k < 32; ++k) rank += (sv[k] > mine || (sv[k] == mine && k < j)) ? 1 : 0;
      if (rank < 8 && mine > 0.5f * NEGBIG) bits |= 1u << j;
    }
    bits |= (unsigned)__builtin_amdgcn_mov_dpp((int)bits, 0xB1, 0xF, 0xF, true);
    bits |= (unsigned)__builtin_amdgcn_mov_dpp((int)bits, 0x4E, 0xF, 0xF, true);
    bits |= (unsigned)__builtin_amdgcn_ds_swizzle((int)bits, 0x1F | (4 << 10));
    if (sub == 0) lds_wu(L + NSA_SELM + tok * 4, bits);
  }
  __syncthreads();
  const unsigned selm = lds_ru(L + NSA_SELM + r32 * 4);
  unsigned umask = 0;
  for (int i = 0; i < 32; ++i) umask |= lds_ru(L + NSA_SELM + i * 4);
  __syncthreads();

  const int krow = tid >> 3, kch = (tid & 7) ^ ((tid >> 4) & 7);
  const int vkey = tid >> 2, vc = tid & 3;
  const unsigned kvo = (unsigned)(krow * 64 + kch * 8) * 2u, vvo = (unsigned)(vkey * 64 + vc * 8) * 2u;
  lptr Lw = L + wv * 1024;
#define N_STAGE(rk, rv, buf, j) do { const unsigned so_ = (unsigned)(j) * 8192u; lptr b_ = Lw + (buf) * NSA_TILE; \
      bdma16(rk, kvo, so_, b_); bdma16(rk, kvo, so_ + 4096u, b_ + 4096); \
      bdma16(rv, vvo, so_, b_ + 8192); bdma16(rv, vvo, so_ + 64u, b_ + 12288); } while (0)
#define N_WAIT(more) do { if (more) asm volatile("s_waitcnt vmcnt(4)" ::: "memory"); else asm volatile("s_waitcnt vmcnt(0)" ::: "memory"); __syncthreads(); } while (0)
  f32x16 osel[2];
#pragma unroll
  for (int db = 0; db < 2; ++db)
#pragma unroll
    for (int r = 0; r < 16; ++r) osel[db][r] = 0.f;
  float msel = 0.f, lsel = 0.f;
  {
    const rsrc_t kg = make_rsrc(proj + (size_t)(36 + hkv) * SLOT + tokbase * 64);
    const rsrc_t vg = make_rsrc(proj + (size_t)(38 + hkv) * SLOT + tokbase * 64);
    auto nextj = [&](int j) { if (j < 0 || j >= 31) return -1; const unsigned rest = umask & ~((2u << j) - 1u); return rest ? (int)__builtin_ctz(rest) : -1; };
    int j0 = __builtin_ctz(umask), j1 = nextj(j0);
    int b0 = 0; bool first = true;
    N_STAGE(kg, vg, 0, j0);
    if (j1 >= 0) N_STAGE(kg, vg, 1, j1);
    N_WAIT(j1 >= 0);
    while (true) {
      const int j2 = nextj(j1);
      const int b2 = b0 == 0 ? 2 : b0 - 1;
      if (j2 >= 0) N_STAGE(kg, vg, b2, j2);
      AdjSel adj{btab + (NSA_M0 - (qpos - j0 * 64 - 4 * hi)) * 4, t0 - (j0 * 64 + 63) >= 128, ((selm >> j0) & 1u) != 0, bfar};
      flash_tile<2>(L + b0 * NSA_TILE, L + b0 * NSA_TILE + 8192, q, osel, msel, lsel, wscr, lane, adj, first);
      first = false;
      N_WAIT(j2 >= 0);
      if (j1 < 0) break;
      j0 = j1; j1 = j2; b0 = b0 == 2 ? 0 : b0 + 1;
    }
  }
  lsel = xor32_sum(lsel);
  if (hi == 0) lds_wf(wscr + 128 + r32 * 4, 1.f / ((1.f + __expf(-gl[1])) * lsel));
#pragma unroll
  for (int r = 0; r < 16; ++r) {
    const float a1 = lds_rf(wscr + hi * 16 + 128 + crow0(r) * 4);
#pragma unroll
    for (int db = 0; db < 2; ++db) { res[db][r] += a1 * osel[db][r]; asm volatile("" : "+v"(res[db][r])); }
  }
  f32x16 owin[2];
#pragma unroll
  for (int db = 0; db < 2; ++db)
#pragma unroll
    for (int r = 0; r < 16; ++r) owin[db][r] = 0.f;
  float mwin = 0.f, lwin = 0.f;
  {
    const rsrc_t kg = make_rsrc(proj + (size_t)(40 + hkv) * SLOT + tokbase * 64);
    const rsrc_t vg = make_rsrc(proj + (size_t)(42 + hkv) * SLOT + tokbase * 64);
    const int jlo = (t0 - 511) > 0 ? (t0 - 511) >> 6 : 0, jhi = (t0 + 31) >> 6;
    int b0 = 0;
    N_STAGE(kg, vg, 0, jlo);
    if (jlo < jhi) N_STAGE(kg, vg, 1, jlo + 1);
    N_WAIT(jlo < jhi);
    for (int j = jlo; j <= jhi; ++j) {
      const int b2 = b0 == 0 ? 2 : b0 - 1;
      if (j + 2 <= jhi) N_STAGE(kg, vg, b2, j + 2);
      AdjWin adj{btab + (NSA_M0 - (qpos - j * 64 - 4 * hi)) * 4, (t0 - (j * 64 + 63) >= 128) && (t0 + 31 - j * 64 <= 511), bfar};
      flash_tile<2>(L + b0 * NSA_TILE, L + b0 * NSA_TILE + 8192, q, owin, mwin, lwin, wscr, lane, adj, j == jlo);
      N_WAIT(j + 2 <= jhi);
      b0 = b0 == 2 ? 0 : b0 + 1;
    }
  }
#undef N_STAGE
#undef N_WAIT
  lwin = xor32_sum(lwin);
  if (hi == 0) lds_wf(wscr + 128 + r32 * 4, 1.f / ((1.f + __expf(-gl[2])) * lwin));
  bf16_t* op = (bf16_t*)(ws + OFF_ATT) + (tokbase + t0 + 4 * hi) * DM + 512 + hq * 64 + r32;
#pragma unroll
  for (int r = 0; r < 16; ++r) {
    const float a2 = lds_rf(wscr + hi * 16 + 128 + crow0(r) * 4);
#pragma unroll
    for (int db = 0; db < 2; ++db) op[crow0(r) * DM + db * 32] = f2bf(res[db][r] + a2 * owin[db][r]);
  }
  __syncthreads();
}
constexpr int T3_END = 2048;
DI void phase3(const Params& p, lptr L, int wv, int bid, int nb) {
  for (int r = 0; r * nb < T3_END; ++r) {
    const int t = r * nb + ((r & 1) ? nb - 1 - bid : bid);
    if (t >= T3_END) continue;
    const int qt = 63 - (t >> 5), bh = t & 31;
    nsa_task(p, L, wv, bh >> 1, bh & 1, qt, t);
  }
}

constexpr int T4_END = 256 * 8;
DI void phase4(const Params& p, lptr L, int wv, int bid, int nb) {
  char* ws = p.ws;
  for_each_tile_patched(bid, nb, 256, 8, [&](int mt, int nt) {
    EpiResid e{p.x, (bf16_t*)(ws + OFF_STASH)};
    gemm_tile((const bf16_t*)(ws + OFF_ATT), DM, (const bf16_t*)(ws + OFF_WOUTT), DM, DM, mt * 128, nt * 128, L, wv, e);
  });
}
DI void rmsnorm_row_b2b(const bf16_t* __restrict__ xr, const float* __restrict__ g, bf16_t* __restrict__ o, int lane) {
  u32x2 v[4]; float f[16]; float ss = 0.f;
#pragma unroll
  for (int i = 0; i < 4; ++i) { v[i] = *(const u32x2*)(xr + lane * 4 + 256 * i); f[4 * i] = bflo(v[i][0]); f[4 * i + 1] = bfhi(v[i][0]); f[4 * i + 2] = bflo(v[i][1]); f[4 * i + 3] = bfhi(v[i][1]); }
#pragma unroll
  for (int i = 0; i < 16; ++i) ss += f[i] * f[i];
  ss = wave_sum(ss);
  const float rs = rsqrtf(ss * (1.f / 1024.f) + 1e-6f);
#pragma unroll
  for (int i = 0; i < 4; ++i) {
    f32x4 gg = *(const f32x4*)(g + lane * 4 + 256 * i);
    *(u32x2*)(o + lane * 4 + 256 * i) = (u32x2){cvtpk(f[4 * i] * rs * gg[0], f[4 * i + 1] * rs * gg[1]), cvtpk(f[4 * i + 2] * rs * gg[2], f[4 * i + 3] * rs * gg[3])};
  }
}
DI void phase5(const Params& p, lptr L, int wv, int bid, int nb) {
  for (int t = bid; t < NTOK / 4; t += nb) {
    const int tid = task_tid(wv);
    const int row = t * 4 + wv;
    rmsnorm_row_b2b((const bf16_t*)(p.ws + OFF_STASH) + (size_t)row * DM, p.g_ffn, (bf16_t*)(p.ws + OFF_XN) + (size_t)row * DM, tid & 63);
  }
}
constexpr int T6_END = 256 * 16;
DI void phase6(const Params& p, lptr L, int wv, int bid, int nb) {
  char* ws = p.ws;
  for_each_tile_patched(bid, nb, 256, 16, [&](int mt, int nt) {
    EpiBf16 e{(bf16_t*)(ws + OFF_PROJ), 2048, 2048};
    gemm_tile((const bf16_t*)(ws + OFF_XN), DM, (const bf16_t*)(ws + OFF_WPT), DM, DM, mt * 128, nt * 128, L, wv, e);
  });
}

DI unsigned fkey(float f) { unsigned u = __float_as_uint(f); return (u & 0x80000000u) ? ~u : (u | 0x80000000u); }
DI float unfkey(unsigned k) { return __uint_as_float((k & 0x80000000u) ? (k & 0x7fffffffu) : ~k); }
DI void ins16(unsigned (&Lst)[16], unsigned x) {
#pragma unroll
  for (int i = 0; i < 16; ++i) { const unsigned t = Lst[i] > x ? Lst[i] : x; x = Lst[i] > x ? x : Lst[i]; Lst[i] = t; }
}
DI unsigned pack_bf(unsigned s16, int n) {
  const unsigned k = (s16 & 0x8000u) ? (~s16 & 0xffffu) : (s16 | 0x8000u);
  return (k << 16) | (unsigned)(127 - n);
}
DI float unpack_bf(unsigned pk) {
  const unsigned k = pk >> 16;
  const unsigned s = (k & 0x8000u) ? (k & 0x7fffu) : (~k & 0xffffu);
  return __uint_as_float(s << 16);
}
DI void cx_desc(unsigned& hi_, unsigned& lo_) { const unsigned a = hi_ > lo_ ? hi_ : lo_, b = hi_ > lo_ ? lo_ : hi_; hi_ = a; lo_ = b; }
DI void bitonic_merge16_desc(unsigned (&a)[16]) {
#pragma unroll
  for (int j = 8; j > 0; j >>= 1)
#pragma unroll
    for (int i = 0; i < 16; ++i) { const int l = i ^ j; if (l > i) cx_desc(a[i], a[l]); }
}
DI void bitonic_sort16_desc(unsigned (&a)[16]) {
#pragma unroll
  for (int k = 2; k <= 16; k <<= 1)
#pragma unroll
    for (int j = k >> 1; j > 0; j >>= 1)
#pragma unroll
      for (int i = 0; i < 16; ++i) {
        const int l = i ^ j;
        if (l > i) { if ((i & k) == 0) cx_desc(a[i], a[l]); else cx_desc(a[l], a[i]); }
      }
}
DI void cxp_desc(unsigned& kh, unsigned& ph, unsigned& kl, unsigned& pl) {
  const bool gt = kh > kl;
  const unsigned a = gt ? kh : kl, b = gt ? kl : kh, pa = gt ? ph : pl, pb = gt ? pl : ph;
  kh = a; kl = b; ph = pa; pl = pb;
}
DI void bitonic_merge16p_desc(unsigned (&a)[16], unsigned (&q)[16]) {
#pragma unroll
  for (int j = 8; j > 0; j >>= 1)
#pragma unroll
    for (int i = 0; i < 16; ++i) { const int l = i ^ j; if (l > i) cxp_desc(a[i], q[i], a[l], q[l]); }
}
DI void bitonic_sort16p_desc(unsigned (&a)[16], unsigned (&q)[16]) {
#pragma unroll
  for (int k = 2; k <= 16; k <<= 1)
#pragma unroll
    for (int j = k >> 1; j > 0; j >>= 1)
#pragma unroll
      for (int i = 0; i < 16; ++i) {
        const int l = i ^ j;
        if (l > i) { if ((i & k) == 0) cxp_desc(a[i], q[i], a[l], q[l]); else cxp_desc(a[l], q[l], a[i], q[i]); }
      }
}
DI void top16_of_sorted_pair(unsigned (&a)[16], unsigned (&q)[16], const unsigned (&b)[16], const unsigned (&r)[16]) {
#pragma unroll
  for (int i = 0; i < 16; ++i) { const bool gt = a[i] > b[15 - i]; a[i] = gt ? a[i] : b[15 - i]; q[i] = gt ? q[i] : r[15 - i]; }
}
DI void top16_half(const u32x4 (&w)[16], unsigned (&Lst)[16]) {
#pragma unroll
  for (int g = 0; g < 8; ++g) {
    unsigned t[16];
#pragma unroll
    for (int e = 0; e < 4; ++e) {
      t[2 * e] = pack_bf(w[2 * g][e] & 0xffffu, g * 16 + 2 * e); t[2 * e + 1] = pack_bf(w[2 * g][e] >> 16, g * 16 + 2 * e + 1);
      t[8 + 2 * e] = pack_bf(w[2 * g + 1][e] & 0xffffu, g * 16 + 8 + 2 * e); t[8 + 2 * e + 1] = pack_bf(w[2 * g + 1][e] >> 16, g * 16 + 8 + 2 * e + 1);
    }
    bitonic_sort16_desc(t);
    if (g == 0) {
#pragma unroll
      for (int i = 0; i < 16; ++i) Lst[i] = t[i];
    } else {
#pragma unroll
      for (int i = 0; i < 16; ++i) Lst[i] = Lst[i] > t[15 - i] ? Lst[i] : t[15 - i];
      bitonic_merge16_desc(Lst);
    }
    __builtin_amdgcn_sched_barrier(0);
  }
}
DI void phase7(const Params& p, lptr L, int wv, int bid, int nb) {
  char* ws = p.ws;
  const int tid = task_tid(wv);
  const bf16_t* S = (const bf16_t*)(ws + OFF_PROJ);
  int* E = (int*)(ws + OFF_PEER_E); float* G = (float*)(ws + OFF_PEER_G);
  for (int task = bid * 256 + tid; task < NTOK * 8; task += nb * 256) {
    const bf16_t* srow = S + (size_t)task * 256;
    u32x4 wa[16], wb[16];
#pragma unroll
    for (int c = 0; c < 16; ++c) { wa[c] = *(const u32x4*)(srow + c * 8); wb[c] = *(const u32x4*)(srow + 128 + c * 8); }
    unsigned A[16], B[16];
    top16_half(wa, A);
    top16_half(wb, B);
    float av[16], bv[16];
#pragma unroll
    for (int i = 0; i < 16; ++i) { av[i] = unpack_bf(A[i]); bv[i] = unpack_bf(B[i]); }
#define CAND_K(i, j) ((fkey(av[i] + bv[j]) & 0xffffff00u) | (unsigned)(255 - ((i) * 16 + (j))))
#define CAND_P(i, j) ((127u - (A[i] & 127u)) * 128u + (127u - (B[j] & 127u)))
    unsigned CK[16], CP[16], DK[16], DP[16];
#pragma unroll
    for (int j = 0; j < 16; ++j) { CK[j] = CAND_K(0, j); CP[j] = CAND_P(0, j); }
    bitonic_sort16p_desc(CK, CP);
#pragma unroll
    for (int j = 0; j < 8; ++j) { DK[j] = CAND_K(1, j); DP[j] = CAND_P(1, j); }
#pragma unroll
    for (int j = 0; j < 5; ++j) { DK[8 + j] = CAND_K(2, j); DP[8 + j] = CAND_P(2, j); }
#pragma unroll
    for (int j = 0; j < 3; ++j) { DK[13 + j] = CAND_K(3, j); DP[13 + j] = CAND_P(3, j); }
    bitonic_sort16p_desc(DK, DP);
    top16_of_sorted_pair(CK, CP, DK, DP);
    bitonic_merge16p_desc(CK, CP);
    DK[0] = CAND_K(3, 3); DP[0] = CAND_P(3, 3);
#pragma unroll
    for (int j = 0; j < 3; ++j) { DK[1 + j] = CAND_K(4, j); DP[1 + j] = CAND_P(4, j); }
#pragma unroll
    for (int i = 5; i < 8; ++i) { DK[4 + 2 * (i - 5)] = CAND_K(i, 0); DP[4 + 2 * (i - 5)] = CAND_P(i, 0); DK[5 + 2 * (i - 5)] = CAND_K(i, 1); DP[5 + 2 * (i - 5)] = CAND_P(i, 1); }
#pragma unroll
    for (int i = 8; i < 14; ++i) { DK[10 + (i - 8)] = CAND_K(i, 0); DP[10 + (i - 8)] = CAND_P(i, 0); }
    bitonic_sort16p_desc(DK, DP);
#pragma unroll
    for (int i = 14; i < 16; ++i) {
      unsigned k = CAND_K(i, 0), pl = CAND_P(i, 0);
#pragma unroll
      for (int s2 = 0; s2 < 16; ++s2) cxp_desc(DK[s2], DP[s2], k, pl);
    }
    top16_of_sorted_pair(CK, CP, DK, DP);
#undef CAND_K
#undef CAND_P
    float cv[16], sm = 0.f;
    unsigned kmax = CK[0];
#pragma unroll
    for (int i = 1; i < 16; ++i) kmax = kmax > CK[i] ? kmax : CK[i];
    const float mx = unfkey(kmax & 0xffffff00u);
#pragma unroll
    for (int i = 0; i < 16; ++i) { cv[i] = __expf(unfkey(CK[i] & 0xffffff00u) - mx); sm += cv[i]; }
    const float inv = 1.f / sm;
    int* eo = E + (size_t)task * 16; float* go = G + (size_t)task * 16;
#pragma unroll
    for (int i = 0; i < 4; ++i) {
      *(u32x4*)(eo + 4 * i) = (u32x4){CP[4 * i], CP[4 * i + 1], CP[4 * i + 2], CP[4 * i + 3]};
      *(f32x4*)(go + 4 * i) = (f32x4){cv[4 * i] * inv, cv[4 * i + 1] * inv, cv[4 * i + 2] * inv, cv[4 * i + 3] * inv};
    }
  }
}

DI void dec16(const u32x2& w, float (&f)[16]) {
#pragma unroll
  for (int d = 0; d < 2; ++d) {
    const f32v2_t a = __builtin_amdgcn_cvt_scalef32_pk_f32_fp4(w[d], 1.0f, 0), b = __builtin_amdgcn_cvt_scalef32_pk_f32_fp4(w[d], 1.0f, 1);
    const f32v2_t c = __builtin_amdgcn_cvt_scalef32_pk_f32_fp4(w[d], 1.0f, 2), e = __builtin_amdgcn_cvt_scalef32_pk_f32_fp4(w[d], 1.0f, 3);
    f[8 * d] = a[0]; f[8 * d + 1] = a[1]; f[8 * d + 2] = b[0]; f[8 * d + 3] = b[1];
    f[8 * d + 4] = c[0]; f[8 * d + 5] = c[1]; f[8 * d + 6] = e[0]; f[8 * d + 7] = e[1];
  }
}
DI void phase8(const Params& p, lptr L, int wv, int bid, int nb, float* dst) {
  char* ws = p.ws;
  const int tid = task_tid(wv), lane = tid & 63, w = wv;
  const auto rsU = __builtin_amdgcn_make_buffer_rsrc((void*)(ws + OFF_U), 0, 8 << 20, 0x00020000);
  const auto rsV = __builtin_amdgcn_make_buffer_rsrc((void*)(ws + OFF_V), 0, 8 << 20, 0x00020000);
  const float* SU = (const float*)(ws + OFF_U + 16 * MiB); const float* SV = (const float*)(ws + OFF_V + 16 * MiB);
  const int* E = (const int*)(ws + OFF_PEER_E); const float* G = (const float*)(ws + OFF_PEER_G);
  for (int tok = bid * 4 + w; tok < NTOK; tok += nb * 4) {
    const bf16_t* xr = (const bf16_t*)(ws + OFF_XN) + (size_t)tok * DM + lane * 4;
    float xa[16];
#pragma unroll
    for (int i = 0; i < 4; ++i) { const u32x2 a = *(const u32x2*)(xr + 256 * i); xa[4 * i] = bflo(a[0]); xa[4 * i + 1] = bfhi(a[0]); xa[4 * i + 2] = bflo(a[1]); xa[4 * i + 3] = bfhi(a[1]); }
    float acc[16];
#pragma unroll
    for (int i = 0; i < 16; ++i) acc[i] = 0.f;
    const int e_lo = E[(size_t)tok * 128 + lane], e_hi = E[(size_t)tok * 128 + 64 + lane];
    const float g_lo = G[(size_t)tok * 128 + lane], g_hi = G[(size_t)tok * 128 + 64 + lane];
    const float su_lo = SU[e_lo], su_hi = SU[e_hi], sv_lo = SV[e_lo], sv_hi = SV[e_hi];
#pragma unroll 1
    for (int hb = 0; hb < 8; ++hb) {
      const int e = (hb & 4) ? e_hi : e_lo;
      const int l0 = (hb & 3) * 16;
      u32x2 ur[16], vr[16];
#pragma unroll
      for (int k = 0; k < 16; ++k) { const int ek = __builtin_amdgcn_readlane(e, l0 + k); ur[k] = __builtin_amdgcn_raw_buffer_load_b64(rsU, lane * 8, ek * 512, PEER_AUX); }
#pragma unroll
      for (int k = 0; k < 16; ++k) { const int ek = __builtin_amdgcn_readlane(e, l0 + k); vr[k] = __builtin_amdgcn_raw_buffer_load_b64(rsV, lane * 8, ek * 512, PEER_AUX); }
      const int src = (l0 + (lane >> 2)) * 4;
      const float gk = __uint_as_float(__builtin_amdgcn_ds_bpermute(src, __float_as_uint((hb & 4) ? g_hi : g_lo)));
      const float suk = __uint_as_float(__builtin_amdgcn_ds_bpermute(src, __float_as_uint((hb & 4) ? su_hi : su_lo)));
      const float svk = __uint_as_float(__builtin_amdgcn_ds_bpermute(src, __float_as_uint((hb & 4) ? sv_hi : sv_lo)));
      __builtin_amdgcn_sched_barrier(0);
      float dp[16];
#pragma unroll
      for (int k = 0; k < 16; ++k) {
        float f[16]; dec16(ur[k], f);
        float s0 = 0.f, s1 = 0.f;
#pragma unroll
        for (int i = 0; i < 8; ++i) { s0 += xa[2 * i] * f[2 * i]; s1 += xa[2 * i + 1] * f[2 * i + 1]; }
        dp[k] = s0 + s1;
      }
      __builtin_amdgcn_sched_barrier(0);
      float t8[8], t4[4], t2[2], z;
      { const bool b = (lane & 32) != 0;
#pragma unroll
        for (int i = 0; i < 8; ++i) { const float snd = b ? dp[i] : dp[i + 8], kp = b ? dp[i + 8] : dp[i]; t8[i] = kp + __shfl_xor(snd, 32); } }
      { const bool b = (lane & 16) != 0;
#pragma unroll
        for (int i = 0; i < 4; ++i) { const float snd = b ? t8[i] : t8[i + 4], kp = b ? t8[i + 4] : t8[i]; t4[i] = kp + __shfl_xor(snd, 16); } }
      { const bool b = (lane & 8) != 0;
#pragma unroll
        for (int i = 0; i < 2; ++i) { const float snd = b ? t4[i] : t4[i + 2], kp = b ? t4[i + 2] : t4[i]; t2[i] = kp + __shfl_xor(snd, 8); } }
      { const bool b = (lane & 4) != 0; const float snd = b ? t2[0] : t2[1], kp = b ? t2[1] : t2[0]; z = kp + __shfl_xor(snd, 4); }
      z += __shfl_xor(z, 2); z += __shfl_xor(z, 1);
      const float wgt = gk * gelu_tanh(z * suk) * svk;
      __builtin_amdgcn_sched_barrier(0);
#pragma unroll
      for (int k = 0; k < 16; ++k) {
        const float wk = __uint_as_float(__builtin_amdgcn_readlane(__float_as_uint(wgt), 4 * k));
        float f[16]; dec16(vr[k], f);
#pragma unroll
        for (int i = 0; i < 16; ++i) acc[i] += wk * f[i];
      }
    }
    const bf16_t* orow = (const bf16_t*)(ws + OFF_STASH) + (size_t)tok * DM + lane * 4;
    float* drow = dst + (size_t)tok * DM + lane * 4;
    float ss = 0.f;
#pragma unroll
    for (int i = 0; i < 4; ++i) {
      const u32x2 ab = *(const u32x2*)(orow + 256 * i);
      const f32x4 a = {bflo(ab[0]), bfhi(ab[0]), bflo(ab[1]), bfhi(ab[1])};
#pragma unroll
      for (int k = 0; k < 4; ++k) { acc[4 * i + k] += a[k]; ss += acc[4 * i + k] * acc[4 * i + k]; }
    }
    ss = wave_sum(ss);
    const float rs = rsqrtf(ss * (1.f / 1024.f) + 1e-6f);
    const float* gf = p.g_fin + lane * 4;
#pragma unroll
    for (int i = 0; i < 4; ++i) {
      f32x4 gg = *(const f32x4*)(gf + 256 * i), a;
#pragma unroll
      for (int k = 0; k < 4; ++k) a[k] = acc[4 * i + k] * rs * gg[k];
      *(f32x4*)(drow + 256 * i) = a;
    }
  }
}

#define XB_TMO      128
#define XB_XCNT(j)  (256  + 64 * (j))
#define XB_XSUB(j)  (1280 + 64 * (j))
#define XB_XGEN(j)  (2304 + 64 * (j))
#define XB_TOP      3328
#define XB_TOPGEN   3392
#define XCD_BAR_WORDS 3456
#define XB_SPIN_CAP (1u << 22)
#define LAS __attribute__((address_space(3)))
DI unsigned xb_ld(unsigned* p)              { return __hip_atomic_load(p, __ATOMIC_RELAXED, __HIP_MEMORY_SCOPE_AGENT); }
DI unsigned xb_add(unsigned* p, unsigned v) { return __hip_atomic_fetch_add(p, v, __ATOMIC_RELAXED, __HIP_MEMORY_SCOPE_AGENT); }
DI unsigned xb_xcc_id() { return (unsigned)__builtin_amdgcn_s_getreg((3 << 11) | 20) & 0xFu; }
#define XB_SPIN(cond, bar) do { unsigned _sp = 0; while (cond) { __builtin_amdgcn_s_sleep(1); \
    if ((++_sp & 255u) == 0u) { if (xb_ld(&(bar)[XB_TMO])) break; if (_sp > XB_SPIN_CAP) { atomicAdd(&(bar)[XB_TMO], 1u); break; } } } } while (0)
struct XcdBarrier { unsigned* bar; unsigned x; volatile LAS unsigned* st; };
DI XcdBarrier xcd_barrier_post(unsigned* bar, volatile LAS unsigned* st) {
  XcdBarrier b; b.bar = bar; b.x = xb_xcc_id(); b.st = st;
  if (threadIdx.x == 0) (void)xb_add(&bar[XB_XCNT(b.x)], 1u);
  return b;
}
DI void xcd_barrier_complete(unsigned* bar, unsigned x, unsigned& nloc, unsigned& nx) {
  const unsigned G = gridDim.x * gridDim.y * gridDim.z;
  unsigned sum, cnt, mine, sp = 0u;
  for (;;) {
    sum = 0u; cnt = 0u; mine = 0u;
#pragma unroll
    for (unsigned j = 0; j < 16; ++j) { const unsigned c = xb_ld(&bar[XB_XCNT(j)]); sum += c; cnt += (c > 0u) ? 1u : 0u; mine = (j == x) ? c : mine; }
    if (sum == G) break;
    __builtin_amdgcn_s_sleep(1);
    if ((++sp & 255u) == 0u) { if (xb_ld(&bar[XB_TMO])) break; if (sp > XB_SPIN_CAP) { atomicAdd(&bar[XB_TMO], 1u); break; } }
  }
  nloc = mine > 0u ? mine : 1u; nx = cnt > 0u ? cnt : 1u;
}
DI void xcd_barrier(const XcdBarrier& b) {
  asm volatile("s_waitcnt vmcnt(0)" ::: "memory");
  __syncthreads();
  if (threadIdx.x == 0) {
    unsigned* bar = b.bar;
    __builtin_amdgcn_s_waitcnt(0);
    unsigned nloc = b.st[0], nx = b.st[1];
    if (nloc == 0u) { xcd_barrier_complete(bar, b.x, nloc, nx); b.st[0] = nloc; b.st[1] = nx; }
    const unsigned old = xb_add(&bar[XB_XSUB(b.x)], 1u);
    const unsigned gen = old / nloc;
    if (old + 1u == (gen + 1u) * nloc) {
      __builtin_amdgcn_fence(__ATOMIC_RELEASE, "agent");
      asm volatile("s_waitcnt vmcnt(0)" ::: "memory");
      const unsigned og = xb_add(&bar[XB_TOP], 1u);
      const unsigned tg = og / nx;
      if (og + 1u == (tg + 1u) * nx) xb_add(&bar[XB_TOPGEN], 1u);
      else XB_SPIN(xb_ld(&bar[XB_TOPGEN]) == tg, bar);
      __builtin_amdgcn_fence(__ATOMIC_ACQUIRE, "agent");
      xb_add(&bar[XB_XGEN(b.x)], 1u);
      asm volatile("s_waitcnt vmcnt(0)" ::: "memory");
    } else {
      XB_SPIN(xb_ld(&bar[XB_XGEN(b.x)]) == gen, bar);
      __builtin_amdgcn_fence(__ATOMIC_ACQUIRE, "agent");
      asm volatile("s_waitcnt vmcnt(0)" ::: "memory");
    }
  }
  __syncthreads();
}

#if !MEGA
#define PHASE_KERNEL(name, fn) \
  __global__ void __launch_bounds__(256, 2) name(Params p) { \
    __shared__ __attribute__((aligned(16))) char lds_[LDS_BYTES]; \
    fn(p, (lptr)lds_, __builtin_amdgcn_readfirstlane(threadIdx.x >> 6), blockIdx.x, gridDim.x); }
PHASE_KERNEL(k_phase0, phase0)
PHASE_KERNEL(k_phase1, phase1)
PHASE_KERNEL(k_phase2, phase2)
PHASE_KERNEL(k_phase2b, phase2b)
PHASE_KERNEL(k_phase3, phase3)
PHASE_KERNEL(k_phase4, phase4)
PHASE_KERNEL(k_phase5, phase5)
PHASE_KERNEL(k_phase6, phase6)
PHASE_KERNEL(k_phase7, phase7)
__global__ void __launch_bounds__(256, 2) k_phase8(Params p) {
  __shared__ __attribute__((aligned(16))) char lds_[LDS_BYTES];
  phase8(p, (lptr)lds_, __builtin_amdgcn_readfirstlane(threadIdx.x >> 6), blockIdx.x, gridDim.x, p.out); }

__global__ void k_dbg_att(Params p) {
  const bf16_t* a = (const bf16_t*)(p.ws + OFF_ATT);
  for (size_t i = (size_t)blockIdx.x * 256 + threadIdx.x; i < (size_t)NTOK * DM; i += (size_t)gridDim.x * 256) p.out[i] = bf2f(a[i]);
}
#endif
#if MEGA
__global__ void __launch_bounds__(256, 2) k_mega(Params p) {
  __shared__ __attribute__((aligned(16))) char lds_[LDS_BYTES];
  cg::grid_group grid = cg::this_grid();
  lptr L = (lptr)lds_;
  const int bid = blockIdx.x, nb = gridDim.x, wv = __builtin_amdgcn_readfirstlane(threadIdx.x >> 6);
  volatile LAS unsigned* bst = (volatile LAS unsigned*)(L + LDS_BYTES - 16);
  if (threadIdx.x == 0) { bst[0] = 0u; bst[1] = 0u; bst[2] = 0u; bst[3] = 0u; }
  __syncthreads();
  const XcdBarrier xb = xcd_barrier_post((unsigned*)(p.ws + OFF_BAR), bst);
#define GSYNC() xcd_barrier(xb)
  if (p.ws == nullptr) grid.sync();
  phase0(p, L, wv, bid, nb); GSYNC();
#if DUP == 0
  phase0(p, L, wv, bid, nb); GSYNC();
#endif
  phase1(p, L, wv, bid, nb); GSYNC();
#if DUP == 1
  phase1(p, L, wv, bid, nb); GSYNC();
#endif
  phase2(p, L, wv, bid, nb); GSYNC();
#if DUP == 2
  phase2(p, L, wv, bid, nb); GSYNC();
#endif
  phase2b(p, L, wv, bid, nb); GSYNC();
  phase3(p, L, wv, bid, nb); GSYNC();
#if DUP == 3
  phase3(p, L, wv, bid, nb); GSYNC();
#endif
  phase4(p, L, wv, bid, nb); GSYNC();
#if DUP == 4
  phase4(p, L, wv, bid, nb); GSYNC();
#endif
  phase5(p, L, wv, bid, nb); GSYNC();
#if DUP == 5
  phase5(p, L, wv, bid, nb); GSYNC();
#endif
  phase6(p, L, wv, bid, nb); GSYNC();
#if DUP == 6
  phase6(p, L, wv, bid, nb); GSYNC();
#endif
  phase7(p, L, wv, bid, nb); GSYNC();
#if DUP == 7
  phase7(p, L, wv, bid, nb); GSYNC();
#endif
#if DUP == 8
  phase8(p, L, wv, bid, nb, (float*)(p.ws + OFF_PROJ)); GSYNC();
#endif
  phase8(p, L, wv, bid, nb, p.out);
}
#endif

extern "C" void kernel_launch(void* const* d_in, const int* in_sizes, int n_in, void* d_out, int out_size, void* d_ws, size_t ws_size, hipStream_t stream) {
  Params p{};
  const float** pp = (const float**)&p;
  for (int i = 0; i < 22; ++i) pp[i] = (const float*)d_in[i];
  p.out = (float*)d_out;
  p.ws = (char*)d_ws;
  if (ws_size < OFF_END) { fprintf(stderr, "kernel_launch: workspace too small (%zu < %zu)\n", ws_size, (size_t)OFF_END); return; }
#if MEGA
  static int grid_blocks = 0;
  if (!grid_blocks) {
    int dev = 0, cus = 0, per_cu = 0;
    hipGetDevice(&dev);
    hipDeviceGetAttribute(&cus, hipDeviceAttributeMultiprocessorCount, dev);
    hipOccupancyMaxActiveBlocksPerMultiprocessor(&per_cu, k_mega, 256, 0);
    if (per_cu > 2) per_cu = 2;
    if (per_cu < 1) per_cu = 1;
    grid_blocks = cus * per_cu;
  }
  hipMemsetAsync((char*)d_ws + OFF_BAR, 0, XCD_BAR_WORDS * 4, stream);
  void* args[] = {&p};
  hipError_t e = hipLaunchCooperativeKernel((void*)k_mega, dim3(grid_blocks), dim3(256), args, 0, stream);
  if (e != hipSuccess) fprintf(stderr, "cooperative launch failed: %s (grid %d)\n", hipGetErrorString(e), grid_blocks);
#else
  const int G = 1024;
#if DBG == 1
  k_phase0<<<G, 256, 0, stream>>>(p);
  k_phase1<<<G, 256, 0, stream>>>(p);
  k_phase2<<<G, 256, 0, stream>>>(p);
  k_phase2b<<<64, 256, 0, stream>>>(p);
  k_phase3<<<G, 256, 0, stream>>>(p);
  k_dbg_att<<<G, 256, 0, stream>>>(p);
  return;
#endif
  k_phase0<<<G, 256, 0, stream>>>(p);
  k_phase1<<<G, 256, 0, stream>>>(p);
  k_phase2<<<G, 256, 0, stream>>>(p);
  k_phase2b<<<64, 256, 0, stream>>>(p);
  k_phase3<<<G, 256, 0, stream>>>(p);
  k_phase4<<<G, 256, 0, stream>>>(p);
  k_phase5<<<G, 256, 0, stream>>>(p);
  k_phase6<<<G, 256, 0, stream>>>(p);
  k_phase7<<<G, 256, 0, stream>>>(p);
  k_phase8<<<G, 256, 0, stream>>>(p);
#endif
}
```
